# Optimizing an MI355X kernel written in HIP

```python
import math
import jax, jax.numpy as jnp
from jax import lax
import numpy as np


D_MODEL = 1024
BATCH = 8
SEQ = 2048
DEPTH = 4

GRID_W = 64
CTX_LEN = 256
N_EVEN = (DEPTH + 1) // 2
N_ODD = DEPTH // 2
NORM_EPS = 1e-6
N_MOD = 6

SSD_WIDTH = D_MODEL
SSD_HEAD_DIM = 64
SSD_HEADS = SSD_WIDTH // SSD_HEAD_DIM
SSD_STATE = 128
SSD_GROUPS = 2
SSD_CONV = 3
SSD_CHUNK = 128
SSD_XBC = SSD_WIDTH + 2 * SSD_GROUPS * SSD_STATE
DT_PROJ_SCALE = 0.1
HY_WIDTH = D_MODEL
HY_SHORT = 3
HY_BANDS = 16
HY_EMB = 1 + 2 * HY_BANDS
HY_FFN = 64
HY_FAST_DECAY = 0.3
HY_SLOW_DECAY = 1.5
HY_DECAY_TARGET = 1e-2
COL_XBC = SSD_WIDTH
COL_DT = COL_XBC + SSD_XBC
COL_HY = COL_DT + 2 * SSD_HEADS
IN_COLS = COL_HY + 3 * HY_WIDTH
MIX_WIDTH = SSD_WIDTH + HY_WIDTH
ATTN_HEAD_DIM = 64
ATTN_Q_HEADS = 16
ATTN_KV_HEADS = 4
ATTN_GROUP = ATTN_Q_HEADS // ATTN_KV_HEADS
ATTN_Q_WIDTH = ATTN_Q_HEADS * ATTN_HEAD_DIM
ATTN_KV_WIDTH = ATTN_KV_HEADS * ATTN_HEAD_DIM
QKV_COLS = ATTN_Q_WIDTH + 2 * ATTN_KV_WIDTH
ATTN_SCALE = ATTN_HEAD_DIM ** -0.5
WINDOW = 128
ATTN_BLOCK = 128
ROPE_BASE = 10000.0
FFN_HIDDEN = -(-8 * D_MODEL // (3 * 256)) * 256

kernel_name = 'hybrid_ssd_hyena_swa_flow_block'


def rmsnorm(t, g):
    t32 = t.astype(jnp.float32)
    y = t32 * lax.rsqrt(jnp.mean(t32 * t32, axis=-1, keepdims=True) + NORM_EPS)
    return (y * g.astype(jnp.float32)).astype(t.dtype)


def conv_centred(t, w, b):
    k_w = w.shape[0]
    pad = (k_w - 1) // 2
    L = t.shape[1]
    tp = jnp.pad(t, ((0, 0), (pad, k_w - 1 - pad), (0, 0)))
    out = tp[:, 0:L] * w[0]
    for k in range(1, k_w):
        out = out + tp[:, k:k + L] * w[k]
    return out + b


def axial_rope(t):
    L = t.shape[1]
    rows = L // GRID_W
    row = jnp.repeat(jnp.arange(rows), GRID_W).astype(jnp.float32)
    col = jnp.tile(jnp.arange(GRID_W), rows).astype(jnp.float32)
    half = t.shape[-1] // 2
    nf = half // 2
    inv = ROPE_BASE ** (-jnp.arange(nf, dtype=jnp.float32) / nf)

    def rot(u, pos):
        ang = (pos[:, None] * inv[None, :])[None, :, None, :]
        cos, sin = jnp.cos(ang), jnp.sin(ang)
        u1, u2 = u[..., :nf], u[..., nf:]
        return jnp.concatenate([u1 * cos - u2 * sin, u2 * cos + u1 * sin], axis=-1)

    t32 = t.astype(jnp.float32)
    return jnp.concatenate([rot(t32[..., :half], row), rot(t32[..., half:], col)], axis=-1).astype(t.dtype)


def ssd_chunked(x, dt, a_neg, bm, cm, h0):
    b, L, H, P = x.shape
    G, N = bm.shape[2], bm.shape[3]
    R = H // G
    Q = SSD_CHUNK
    nc = L // Q
    xc = (x.astype(jnp.float32) * dt[..., None]).reshape(b, nc, Q, G, R, P)
    acum = jnp.cumsum((dt * a_neg).reshape(b, nc, Q, G, R), axis=2)
    bc = bm.astype(jnp.float32).reshape(b, nc, Q, G, N)
    cc = cm.astype(jnp.float32).reshape(b, nc, Q, G, N)
    tri = jnp.tril(jnp.ones((Q, Q), dtype=bool))
    seg = acum[:, :, :, None] - acum[:, :, None, :]
    lmat = jnp.exp(jnp.where(tri[None, None, :, :, None, None], seg, -jnp.inf))
    cb = jnp.einsum('bcign,bcjgn->bcijg', cc, bc)
    y_diag = jnp.einsum('bcijg,bcijgr,bcjgrp->bcigrp', cb, lmat, xc)
    decay_to_end = jnp.exp(acum[:, :, -1:] - acum)
    states = jnp.einsum('bcjgn,bcjgr,bcjgrp->bcgrpn', bc, decay_to_end, xc)
    chunk_decay = jnp.exp(acum[:, :, -1])

    def step(h, inp):
        st, dec = inp
        return h * dec[..., None, None] + st, h

    h_last, h_in = lax.scan(step, h0.reshape(b, G, R, P, N).astype(jnp.float32),
                            (jnp.moveaxis(states, 1, 0), jnp.moveaxis(chunk_decay, 1, 0)))
    h_in = jnp.moveaxis(h_in, 0, 1)
    y_off = jnp.einsum('bcign,bcigr,bcgrpn->bcigrp', cc, jnp.exp(acum), h_in)
    return (y_diag + y_off).reshape(b, L, H, P), h_last.reshape(b, H, P, N)


def bidir_ssd(seq_c, seq_l, a_f, a_b, d_skip):
    xc, dfc, dbc, bmc, cmc = seq_c
    xl, dfl, dbl, bml, cml = seq_l
    b, _, H, P = xc.shape
    h0 = jnp.zeros((b, H, P, bmc.shape[-1]), jnp.float32)
    fl = lambda t: jnp.flip(t, axis=1)
    y_cf, s_cf = ssd_chunked(xc, dfc, a_f, bmc, cmc, h0)
    y_lf, _ = ssd_chunked(xl, dfl, a_f, bml, cml, s_cf)
    y_cb, s_cb = ssd_chunked(fl(xc), fl(dbc), a_b, fl(bmc), fl(cmc), h0)
    y_lb, _ = ssd_chunked(fl(xl), fl(dbl), a_b, fl(bml), fl(cml), s_cb)
    y_c = y_cf + fl(y_cb) + d_skip[:, None] * xc.astype(jnp.float32)
    y_l = y_lf + fl(y_lb) + d_skip[:, None] * xl.astype(jnp.float32)
    return y_c, y_l


def hyena_filter(L, w1, b1, w2, b2, w3, b3, w4, freq):
    t = jnp.arange(L, dtype=jnp.float32)
    t_unit = t / (L - 1)
    ang = 2.0 * math.pi * t / L
    f = jnp.linspace(1e-4, HY_BANDS - 1, HY_BANDS, dtype=jnp.float32)
    z = jnp.concatenate([t_unit[:, None], jnp.cos(ang[:, None] * f), -jnp.sin(ang[:, None] * f)], axis=-1)
    h = jnp.sin(freq[0] * (z @ w1 + b1))
    h = jnp.sin(freq[1] * (h @ w2 + b2))
    h = jnp.sin(freq[2] * (h @ w3 + b3))
    h = (h @ w4).astype(jnp.float32)
    max_decay = math.log(HY_DECAY_TARGET) / HY_FAST_DECAY
    min_decay = math.log(HY_DECAY_TARGET) / HY_SLOW_DECAY
    deltas = jnp.linspace(min_decay, max_decay, HY_WIDTH, dtype=jnp.float32)
    window = jnp.exp(-t_unit[:, None] * jnp.abs(deltas)[None, :])
    h_fwd = h[:, :HY_WIDTH] * window
    h_bwd = h[:, HY_WIDTH:] * window
    k = jnp.concatenate([h_fwd, jnp.zeros((1, HY_WIDTH), jnp.float32), h_bwd[1:][::-1]], axis=0)
    return k * lax.rsqrt(jnp.sum(k * k, axis=0, keepdims=True) + 1e-6)


def long_conv(u, k):
    L = u.shape[1]
    uf = jnp.fft.rfft(u.astype(jnp.float32), n=2 * L, axis=1)
    kf = jnp.fft.rfft(k, n=2 * L, axis=0)
    return jnp.fft.irfft(uf * kf[None], n=2 * L, axis=1)[:, :L]


def hyena_op(hp, conv_w, conv_b, filt, bias):
    hp = conv_centred(hp, conv_w, conv_b)
    x0, x1, v = jnp.split(hp, 3, axis=-1)
    u = (x1 * v).astype(jnp.float32)
    k = hyena_filter(hp.shape[1], *filt)
    y = long_conv(u, k) + bias.astype(jnp.float32) * u
    return (x0.astype(jnp.float32) * y).astype(hp.dtype)


def ssd_hyena_mixer(h_c, h_l, w_in, conv_w, conv_b, dt_bias, a_log, d_skip, norm_g,
                    hy_conv_w, hy_conv_b, hy_filt, hy_bias, w_out, need_ctx):
    G, N = SSD_GROUPS, SSD_STATE

    def prep(h):
        b, L = h.shape[:2]
        p = h @ w_in
        z = p[..., :COL_XBC]
        xbc = jax.nn.silu(conv_centred(p[..., COL_XBC:COL_DT], conv_w, conv_b))
        dt = p[..., COL_DT:COL_HY].astype(jnp.float32)
        hy = p[..., COL_HY:]
        xs = xbc[..., :SSD_WIDTH].reshape(b, L, SSD_HEADS, SSD_HEAD_DIM)
        bm = xbc[..., SSD_WIDTH:SSD_WIDTH + G * N].reshape(b, L, G, N)
        cm = xbc[..., SSD_WIDTH + G * N:].reshape(b, L, G, N)
        dt_f = jax.nn.softplus(dt[..., :SSD_HEADS] + dt_bias[0].astype(jnp.float32))
        dt_b = jax.nn.softplus(dt[..., SSD_HEADS:] + dt_bias[1].astype(jnp.float32))
        return z, (xs, dt_f, dt_b, bm, cm), hy

    z_c, seq_c, hy_c = prep(h_c)
    z_l, seq_l, hy_l = prep(h_l)
    a_f = -jnp.exp(a_log[0].astype(jnp.float32))
    a_b = -jnp.exp(a_log[1].astype(jnp.float32))
    y_c, y_l = bidir_ssd(seq_c, seq_l, a_f, a_b, d_skip.astype(jnp.float32))

    def finish(y, z, hy):
        b, L = z.shape[:2]
        y = rmsnorm(y.reshape(b, L, SSD_WIDTH) * jax.nn.silu(z.astype(jnp.float32)), norm_g).astype(z.dtype)
        g = hyena_op(hy, hy_conv_w, hy_conv_b, hy_filt, hy_bias)
        return jnp.concatenate([y, g], axis=-1) @ w_out

    out_l = finish(y_l, z_l, hy_l)
    if not need_ctx:
        return None, out_l
    return finish(y_c, z_c, hy_c), out_l


def sink_softmax(scores, sink):
    s_sink = jnp.broadcast_to(sink.astype(jnp.float32)[None, :, :, None, None], scores.shape[:-1] + (1,))
    p = jax.nn.softmax(jnp.concatenate([scores, s_sink], axis=-1), axis=-1)
    return p[..., :-1]


def windowed_attention(q, k, v, k_c, v_c, sink):
    b, L = q.shape[:2]
    nb = L // ATTN_BLOCK
    span = ATTN_BLOCK + 2 * WINDOW
    kp = jnp.pad(k, ((0, 0), (WINDOW, WINDOW), (0, 0), (0, 0)))
    vp = jnp.pad(v, ((0, 0), (WINDOW, WINDOW), (0, 0), (0, 0)))

    def block(i):
        start = i * ATTN_BLOCK
        qb = lax.dynamic_slice_in_dim(q, start, ATTN_BLOCK, axis=1)
        kb = lax.dynamic_slice_in_dim(kp, start, span, axis=1)
        vb = lax.dynamic_slice_in_dim(vp, start, span, axis=1)
        qpos = start + jnp.arange(ATTN_BLOCK)
        kpos = start - WINDOW + jnp.arange(span)
        ok = (jnp.abs(qpos[:, None] - kpos[None, :]) <= WINDOW) & (kpos[None, :] >= 0) & (kpos[None, :] < L)
        s_loc = jnp.einsum('bqgrd,bkgd->bgrqk', qb, kb).astype(jnp.float32) * ATTN_SCALE
        s_loc = jnp.where(ok[None, None, None], s_loc, -jnp.inf)
        s_ctx = jnp.einsum('bqgrd,bkgd->bgrqk', qb, k_c).astype(jnp.float32) * ATTN_SCALE
        p = sink_softmax(jnp.concatenate([s_loc, s_ctx], axis=-1), sink).astype(vb.dtype)
        return (jnp.einsum('bgrqk,bkgd->bqgrd', p[..., :span], vb)
                + jnp.einsum('bgrqk,bkgd->bqgrd', p[..., span:], v_c))

    o = lax.map(block, jnp.arange(nb))
    return jnp.moveaxis(o, 0, 1).reshape(b, L, ATTN_Q_WIDTH)


def attn_mixer(h_c, h_l, w_qkv, sinks, w_out, need_ctx):
    def proj(h):
        b, L = h.shape[:2]
        p = h @ w_qkv
        q = p[..., :ATTN_Q_WIDTH].reshape(b, L, ATTN_Q_HEADS, ATTN_HEAD_DIM)
        k = p[..., ATTN_Q_WIDTH:ATTN_Q_WIDTH + ATTN_KV_WIDTH].reshape(b, L, ATTN_KV_HEADS, ATTN_HEAD_DIM)
        v = p[..., ATTN_Q_WIDTH + ATTN_KV_WIDTH:].reshape(b, L, ATTN_KV_HEADS, ATTN_HEAD_DIM)
        return q, k, v

    q_c, k_c, v_c = proj(h_c)
    q_l, k_l, v_l = proj(h_l)
    q_l, k_l = axial_rope(q_l), axial_rope(k_l)
    sink = sinks.reshape(ATTN_KV_HEADS, ATTN_GROUP)
    b, L = h_l.shape[:2]
    o_l = windowed_attention(q_l.reshape(b, L, ATTN_KV_HEADS, ATTN_GROUP, ATTN_HEAD_DIM), k_l, v_l, k_c, v_c, sink)
    out_l = o_l @ w_out
    if not need_ctx:
        return None, out_l
    lc = h_c.shape[1]
    qg = q_c.reshape(b, lc, ATTN_KV_HEADS, ATTN_GROUP, ATTN_HEAD_DIM)
    s = jnp.einsum('bqgrd,bkgd->bgrqk', qg, k_c).astype(jnp.float32) * ATTN_SCALE
    p = sink_softmax(s, sink).astype(v_c.dtype)
    o_c = jnp.einsum('bgrqk,bkgd->bqgrd', p, v_c).reshape(b, lc, ATTN_Q_WIDTH)
    return o_c @ w_out, out_l


def swiglu(h, w_in, w_out):
    gu = h @ w_in
    return (jax.nn.silu(gu[..., :FFN_HIDDEN]) * gu[..., FFN_HIDDEN:]) @ w_out


def setup_inputs(seed: int = 0) -> dict:
    key = jax.random.key(seed)
    k = jax.random.split(key, 40)
    d = D_MODEL

    def nrm(kk, shape, scale):
        return scale * jax.random.normal(kk, shape, jnp.float32)

    hy_in_w = nrm(k[8], (N_EVEN, d, IN_COLS), d ** -0.5)
    hy_in_w = hy_in_w.at[:, :, COL_DT:COL_HY].multiply(DT_PROJ_SCALE)
    dt0 = jnp.exp(jax.random.uniform(k[11], (N_EVEN, 2, SSD_HEADS), jnp.float32, math.log(1e-3), math.log(1e-1)))
    ssd_dt_bias = dt0 + jnp.log(-jnp.expm1(-dt0))
    ssd_a_log = jnp.log(jax.random.uniform(k[12], (N_EVEN, 2, SSD_HEADS), jnp.float32, 1.0, 16.0))
    return {
        'x': nrm(k[0], (BATCH, SEQ, d), 1.0),
        'c': nrm(k[1], (BATCH, d), 1.0),
        'ctx': nrm(k[2], (BATCH, CTX_LEN, d), 1.0),
        'c_ctx': nrm(k[3], (d,), 1.0),
        'ada_w': nrm(k[4], (DEPTH, d, N_MOD * d), 0.5 * d ** -0.5),
        'ada_b': nrm(k[5], (DEPTH, N_MOD * d), 0.02),
        'norm1_g': 1.0 + nrm(k[6], (DEPTH, d), 0.05),
        'norm2_g': 1.0 + nrm(k[7], (DEPTH, d), 0.05),
        'hy_in_w': hy_in_w,
        'ssd_conv_w': nrm(k[9], (N_EVEN, SSD_CONV, SSD_XBC), SSD_CONV ** -0.5),
        'ssd_conv_b': nrm(k[10], (N_EVEN, SSD_XBC), 0.02),
        'ssd_dt_bias': ssd_dt_bias,
        'ssd_a_log': ssd_a_log,
        'ssd_d': 1.0 + nrm(k[13], (N_EVEN, SSD_HEADS), 0.1),
        'ssd_norm_g': 1.0 + nrm(k[14], (N_EVEN, SSD_WIDTH), 0.05),
        'hy_conv_w': nrm(k[15], (N_EVEN, HY_SHORT, 3 * HY_WIDTH), HY_SHORT ** -0.5),
        'hy_conv_b': nrm(k[16], (N_EVEN, 3 * HY_WIDTH), 0.02),
        'hy_w1': nrm(k[17], (N_EVEN, HY_EMB, HY_FFN), HY_EMB ** -0.5),
        'hy_b1': nrm(k[18], (N_EVEN, HY_FFN), 0.02),
        'hy_w2': nrm(k[19], (N_EVEN, HY_FFN, HY_FFN), HY_FFN ** -0.5),
        'hy_b2': nrm(k[20], (N_EVEN, HY_FFN), 0.02),
        'hy_w3': nrm(k[21], (N_EVEN, HY_FFN, HY_FFN), HY_FFN ** -0.5),
        'hy_b3': nrm(k[22], (N_EVEN, HY_FFN), 0.02),
        'hy_w4': nrm(k[23], (N_EVEN, HY_FFN, 2 * HY_WIDTH), HY_FFN ** -0.5),
        'hy_freq': 1.0 + nrm(k[24], (N_EVEN, 3, HY_FFN), 0.1),
        'hy_bias': nrm(k[25], (N_EVEN, HY_WIDTH), 0.1),
        'hy_out_w': nrm(k[26], (N_EVEN, MIX_WIDTH, d), MIX_WIDTH ** -0.5),
        'attn_qkv_w': nrm(k[27], (N_ODD, d, QKV_COLS), d ** -0.5),
        'attn_sinks': nrm(k[28], (N_ODD, ATTN_Q_HEADS), 0.5),
        'attn_out_w': nrm(k[29], (N_ODD, ATTN_Q_WIDTH, d), ATTN_Q_WIDTH ** -0.5),
        'ffn_w_in': nrm(k[30], (DEPTH, d, 2 * FFN_HIDDEN), d ** -0.5),
        'ffn_w_out': nrm(k[31], (DEPTH, FFN_HIDDEN, d), FFN_HIDDEN ** -0.5),
        'final_g': 1.0 + nrm(k[32], (d,), 0.05),
    }


def reference(x, c, ctx, c_ctx, ada_w, ada_b, norm1_g, norm2_g, hy_in_w, ssd_conv_w, ssd_conv_b,
              ssd_dt_bias, ssd_a_log, ssd_d, ssd_norm_g, hy_conv_w, hy_conv_b, hy_w1, hy_b1, hy_w2,
              hy_b2, hy_w3, hy_b3, hy_w4, hy_freq, hy_bias, hy_out_w, attn_qkv_w, attn_sinks,
              attn_out_w, ffn_w_in, ffn_w_out, final_g):
    sc = jax.nn.silu(c)
    scc = jax.nn.silu(c_ctx)
    for layer in range(DEPTH):
        need_ctx = layer < DEPTH - 1
        j = layer // 2
        mod_l = jnp.split((sc @ ada_w[layer] + ada_b[layer])[:, None, :], N_MOD, axis=-1)
        mod_c = jnp.split((scc @ ada_w[layer] + ada_b[layer])[None, None, :], N_MOD, axis=-1)
        h_l = rmsnorm(x, norm1_g[layer]) * (1.0 + mod_l[1]) + mod_l[0]
        h_c = rmsnorm(ctx, norm1_g[layer]) * (1.0 + mod_c[1]) + mod_c[0]
        if layer % 2 == 0:
            hy_filt = (hy_w1[j], hy_b1[j], hy_w2[j], hy_b2[j], hy_w3[j], hy_b3[j], hy_w4[j], hy_freq[j])
            o_c, o_l = ssd_hyena_mixer(h_c, h_l, hy_in_w[j], ssd_conv_w[j], ssd_conv_b[j], ssd_dt_bias[j],
                                       ssd_a_log[j], ssd_d[j], ssd_norm_g[j], hy_conv_w[j], hy_conv_b[j],
                                       hy_filt, hy_bias[j], hy_out_w[j], need_ctx)
        else:
            o_c, o_l = attn_mixer(h_c, h_l, attn_qkv_w[j], attn_sinks[j], attn_out_w[j], need_ctx)
        x = x + mod_l[2] * o_l
        h_l = rmsnorm(x, norm2_g[layer]) * (1.0 + mod_l[4]) + mod_l[3]
        x = x + mod_l[5] * swiglu(h_l, ffn_w_in[layer], ffn_w_out[layer])
        if need_ctx:
            ctx = ctx + mod_c[2] * o_c
            h_c = rmsnorm(ctx, norm2_g[layer]) * (1.0 + mod_c[4]) + mod_c[3]
            ctx = ctx + mod_c[5] * swiglu(h_c, ffn_w_in[layer], ffn_w_out[layer])
    return rmsnorm(x, final_g)
```

```cpp
#include <hip/hip_runtime.h>
#include <hip/hip_cooperative_groups.h>
#include <cstdio>
#include <cstdint>
namespace cg = cooperative_groups;

#define LAS __attribute__((address_space(3)))
typedef unsigned short bf16;
typedef unsigned v4u __attribute__((ext_vector_type(4)));
typedef unsigned v2u __attribute__((ext_vector_type(2)));
typedef float f32x4 __attribute__((ext_vector_type(4)));
typedef float f32x16 __attribute__((ext_vector_type(16)));
typedef short bf16x8 __attribute__((ext_vector_type(8)));

constexpr int DM = 1024, NBATCH = 8, SEQ = 2048, CTXL = 256, DEPTH = 4;
constexpr int MLAT = NBATCH * SEQ, MCTX = NBATCH * CTXL, MALL = MLAT + MCTX;
constexpr int NMOD = 6, MODW = NMOD * DM;
constexpr int FFH = 2816;
constexpr int IN_COLS = 5664, INP = 5888;
constexpr int QKV_COLS = 1536;
constexpr float NORM_EPS = 1e-6f;
constexpr int NWAVES = 8, NTHREADS = 512;

constexpr size_t MiB = 1u << 20;
constexpr size_t WS_CTL = 0, CTL_BYTES = 64 * 1024;
constexpr size_t WS_MOD = 1 * MiB;
constexpr size_t WS_ROPE = 2 * MiB;
constexpr size_t WS_F = 3 * MiB;
constexpr size_t F_LAYER = 9 * MiB;
constexpr size_t WS_XC = 21 * MiB;
constexpr size_t WS_WA = 29 * MiB;
constexpr size_t WS_WB = 41 * MiB;
constexpr size_t WS_WC = 45 * MiB;
constexpr size_t WS_WD = 56 * MiB;
constexpr size_t WS_RA = 62 * MiB;
constexpr size_t RA_BYTES = 200 * MiB;
constexpr size_t WS_RB = WS_RA + RA_BYTES;
constexpr size_t RB_BYTES = 72 * MiB;
constexpr size_t WS_Y = WS_RB + RB_BYTES;
constexpr size_t WS_END = WS_Y + 36 * MiB;
constexpr size_t SZ_M1024 = (size_t)MALL * 1024 * 2;
constexpr size_t RA_PZ = 0, RA_PXBC = RA_PZ + SZ_M1024, RA_PX0 = RA_PXBC + (size_t)MALL * 1536 * 2, RA_PX1 = RA_PX0 + SZ_M1024, RA_PV = RA_PX1 + SZ_M1024, RA_PDT = RA_PV + SZ_M1024;
static_assert(RA_PDT + (size_t)MALL * 32 * 2 <= RA_BYTES, "region A (even)");
constexpr size_t RA_Q = 0, RA_K = RA_Q + SZ_M1024, RA_V = RA_K + (size_t)MALL * 256 * 2;
static_assert((size_t)MALL * FFH * 2 <= RA_BYTES, "region A (ffn)");
static_assert(2 * SZ_M1024 <= RB_BYTES, "region B");

typedef float f32x2_t __attribute__((ext_vector_type(2))); typedef __bf16 bf16x2_t __attribute__((ext_vector_type(2)));
__device__ __forceinline__ unsigned pk2(float lo, float hi) { f32x2_t v = {lo, hi}; bf16x2_t b = __builtin_convertvector(v, bf16x2_t); return __builtin_bit_cast(unsigned, b); }
__device__ __forceinline__ unsigned f2bf(float f) { return pk2(f, 0.f) & 0xffffu; }
__device__ __forceinline__ float bf2f(unsigned short h) { return __builtin_bit_cast(float, (unsigned)h << 16); }
__device__ __forceinline__ float bflo(unsigned w) { return __builtin_bit_cast(float, w << 16); }
__device__ __forceinline__ float bfhi(unsigned w) { return __builtin_bit_cast(float, w & 0xffff0000u); }
__device__ __forceinline__ float siluf(float x) { return x * __builtin_amdgcn_rcpf(1.f + __expf(-x)); }
__device__ __forceinline__ float wave_sum(float v) {
    v += __builtin_bit_cast(float, __builtin_amdgcn_update_dpp(0, __builtin_bit_cast(int, v), 0xB1, 0xf, 0xf, false));
    v += __builtin_bit_cast(float, __builtin_amdgcn_update_dpp(0, __builtin_bit_cast(int, v), 0x4E, 0xf, 0xf, false));
    v += __builtin_bit_cast(float, __builtin_amdgcn_update_dpp(0, __builtin_bit_cast(int, v), 0x141, 0xf, 0xf, false));
    v += __builtin_bit_cast(float, __builtin_amdgcn_update_dpp(0, __builtin_bit_cast(int, v), 0x140, 0xf, 0xf, false));
    const float s0 = __builtin_bit_cast(float, __builtin_amdgcn_readlane(__builtin_bit_cast(int, v), 0)), s1 = __builtin_bit_cast(float, __builtin_amdgcn_readlane(__builtin_bit_cast(int, v), 16));
    const float s2 = __builtin_bit_cast(float, __builtin_amdgcn_readlane(__builtin_bit_cast(int, v), 32)), s3 = __builtin_bit_cast(float, __builtin_amdgcn_readlane(__builtin_bit_cast(int, v), 48));
    return (s0 + s1) + (s2 + s3);
}
#define LDS_WAIT() asm volatile("s_waitcnt lgkmcnt(0)" ::: "memory")

struct Args {
    const float* in[33]; float* out; unsigned char* ws; int ph_lo, ph_hi, dry, pad;
};

#define XB_TMO      128
#define XB_XCNT(j)  (256  + 64 * (j))
#define XB_XSUB(j)  (1280 + 64 * (j))
#define XB_XGEN(j)  (2304 + 64 * (j))
#define XB_TOP      3328
#define XB_TOPGEN   3392
#define XCD_BAR_WORDS 3456
#define XB_SPIN_CAP (1u << 18)

__device__ __forceinline__ unsigned xb_ld(unsigned* p)              { return __hip_atomic_load(p, __ATOMIC_RELAXED, __HIP_MEMORY_SCOPE_AGENT); }
__device__ __forceinline__ unsigned xb_add(unsigned* p, unsigned v) { return __hip_atomic_fetch_add(p, v, __ATOMIC_RELAXED, __HIP_MEMORY_SCOPE_AGENT); }
__device__ __forceinline__ unsigned xb_xcc_id() { return (unsigned)__builtin_amdgcn_s_getreg((3 << 11) | 20) & 0xFu; }
#define XB_SPIN(cond, bar) do { unsigned _sp = 0; while (cond) { __builtin_amdgcn_s_sleep(1); \
    if ((++_sp & 255u) == 0u) { if (xb_ld(&(bar)[XB_TMO])) break; if (_sp > XB_SPIN_CAP) { atomicAdd(&(bar)[XB_TMO], 1u); break; } } } } while (0)

struct XcdBarrier {
    unsigned* bar; unsigned x;
    volatile LAS unsigned* st;
};

__device__ __forceinline__ XcdBarrier xcd_barrier_post(unsigned* bar, volatile LAS unsigned* st) {
    XcdBarrier b; b.bar = bar; b.x = xb_xcc_id(); b.st = st;
    if (threadIdx.x == 0) (void)xb_add(&bar[XB_XCNT(b.x)], 1u);
    return b;
}
__device__ __forceinline__ void xcd_barrier_complete(unsigned* bar, unsigned x, unsigned& nloc, unsigned& nx) {
    const unsigned G = gridDim.x * gridDim.y * gridDim.z;
    unsigned sum, cnt, mine, sp = 0u;
    for (;;) {
        sum = 0u; cnt = 0u; mine = 0u;
#pragma unroll
        for (unsigned j = 0; j < 16; ++j) { const unsigned c = xb_ld(&bar[XB_XCNT(j)]); sum += c; cnt += (c > 0u) ? 1u : 0u; mine = (j == x) ? c : mine; }
        if (sum == G) break;
        __builtin_amdgcn_s_sleep(1);
        if ((++sp & 255u) == 0u) { if (xb_ld(&bar[XB_TMO])) break; if (sp > XB_SPIN_CAP) { atomicAdd(&bar[XB_TMO], 1u); break; } }
    }
    nloc = mine > 0u ? mine : 1u; nx = cnt > 0u ? cnt : 1u;
}

__device__ __forceinline__ void xcd_barrier(const XcdBarrier& b) {
    asm volatile("s_waitcnt vmcnt(0)" ::: "memory");
    __syncthreads();
    if (threadIdx.x == 0) {
        unsigned* bar = b.bar;
        __builtin_amdgcn_s_waitcnt(0);
        unsigned nloc = b.st[0], nx = b.st[1];
        if (nloc == 0u) { xcd_barrier_complete(bar, b.x, nloc, nx); b.st[0] = nloc; b.st[1] = nx; }
        const unsigned old = xb_add(&bar[XB_XSUB(b.x)], 1u);
        const unsigned gen = old / nloc;
        if (old + 1u == (gen + 1u) * nloc) {
            __builtin_amdgcn_fence(__ATOMIC_RELEASE, "agent");
            asm volatile("s_waitcnt vmcnt(0)" ::: "memory");
            const unsigned og = xb_add(&bar[XB_TOP], 1u);
            const unsigned tg = og / nx;
            if (og + 1u == (tg + 1u) * nx) xb_add(&bar[XB_TOPGEN], 1u);
            else XB_SPIN(xb_ld(&bar[XB_TOPGEN]) == tg, bar);
            __builtin_amdgcn_fence(__ATOMIC_ACQUIRE, "agent");
            xb_add(&bar[XB_XGEN(b.x)], 1u);
            asm volatile("s_waitcnt vmcnt(0)" ::: "memory");
        } else {
            XB_SPIN(xb_ld(&bar[XB_XGEN(b.x)]) == gen, bar);
            __builtin_amdgcn_fence(__ATOMIC_ACQUIRE, "agent");
            asm volatile("s_waitcnt vmcnt(0)" ::: "memory");
        }
    }
    __syncthreads();
}

namespace pg8 {
#define PG8_LAS __attribute__((address_space(3)))
typedef unsigned short bf16_t;
typedef short bf16x8 __attribute__((ext_vector_type(8)));
typedef float f32x4 __attribute__((ext_vector_type(4)));
typedef unsigned u32x4 __attribute__((ext_vector_type(4)));
constexpr int BM = 256, BK = 64, HALF = 128, HTB = HALF * BK * 2  , STAGE_BYTES = 8 * HTB, NXCD = 8, WGM = 8;

__host__ __device__ __forceinline__ int lds_byte(int r, int c) { const int st = (r >> 4) * 2 + (c >> 5), rr = r & 15, cc = c & 31, ob = rr * 64 + cc * 2; return st * 1024 + (ob ^ (((ob >> 9) & 1) << 5)); }
__host__ __device__ __forceinline__ void stage_rc(int b, int& R, int& C) { const int st = b / 1024, sb = b % 1024, swz = sb ^ (((sb >> 9) & 1) << 5); R = (st >> 1) * 16 + swz / 64; C = (st & 1) * 32 + (swz % 64) / 2; }
__host__ __device__ __forceinline__ int perm32(int rho) { const int n = rho >> 4, i = rho & 15; return 8 * (i >> 2) + 4 * n + (i & 3); }

struct Unit { int pm, pn, kt0, knt, slab; };
struct Gemm { const bf16_t* A; const bf16_t* Bt; int M, N, K; };

struct StaticOrder {
    static constexpr bool SPLIT = false;
    int nM, nN, nwg, G, c;
    __host__ __device__ __forceinline__ void init(int M, int N, int G_, int c_) { nM = M / BM; nN = N / BM; nwg = nM * nN; G = G_; c = c_; }
    __host__ __device__ __forceinline__ bool next(int i, Unit& u) const {
        const long L = (long)i * G + c; if (L >= nwg) return false;
        int wgid = (int)L; { const int q = nwg / NXCD, r = nwg % NXCD, xcd = wgid % NXCD, off = wgid / NXCD; wgid = (xcd < r ? xcd * (q + 1) : r * (q + 1) + (xcd - r) * q) + off; }
        const int nig = WGM * nN, gid = wgid / nig, fm = gid * WGM, gsz = (nM - fm) < WGM ? (nM - fm) : WGM;
        u.pm = fm + ((wgid % nig) % gsz); u.pn = (wgid % nig) / gsz; return true;
    }
    __device__ __forceinline__ void a_ready(const Unit&) const {}
    __device__ __forceinline__ void done(const Unit&) const {}
};

struct SplitOrder {
    static constexpr bool SPLIT = true;
    int nM, nN, nwg, G, c, ntk, full, S, npieces, nMf;
    __host__ __device__ __forceinline__ void init(int M, int N, int K, int G_, int c_, int S_) { nM = M / BM; nN = N / BM; nwg = nM * nN; G = G_; c = c_; ntk = K / BK; full = (nwg / G) * G;
        S = S_; if (full == nwg || S < 1 || (full % nN) != 0 || full == 0) { S = 1; full = nwg; } nMf = full / nN; npieces = (nwg - full) * S; }
    __host__ __device__ __forceinline__ bool next(int i, Unit& u) const {
        const long L = (long)i * G + c;
        if (L < full) {
            int wgid = (int)L; { const int q = full / NXCD, r = full % NXCD, xcd = wgid % NXCD, off = wgid / NXCD; wgid = (xcd < r ? xcd * (q + 1) : r * (q + 1) + (xcd - r) * q) + off; }
            const int nig = WGM * nN, gid = wgid / nig, fm = gid * WGM, gsz = (nMf - fm) < WGM ? (nMf - fm) : WGM;
            u.pm = fm + ((wgid % nig) % gsz); u.pn = (wgid % nig) / gsz; u.kt0 = 0; u.knt = ntk; u.slab = -1; return true; }
        const long P = L - full; if (P >= npieces) return false;
        const int tile = (int)(P / S), s = (int)(P % S); u.pm = nMf + tile / nN; u.pn = tile % nN; const int kb = (ntk / S) & ~1;
        u.kt0 = s * kb; u.knt = s == S - 1 ? ntk - kb * (S - 1) : kb; u.slab = (int)P; return true;
    }
    __device__ __forceinline__ void a_ready(const Unit&) const {}
    __device__ __forceinline__ void done(const Unit&) const {}
};

__device__ __forceinline__ unsigned cvt_pk_bf16(float lo, float hi) { return pk2(lo, hi); }
typedef unsigned u32x2 __attribute__((ext_vector_type(2)));
template <class Epi, class Sched, bool ALIGN_EPI = false, bool SP2 = false>
__device__ __forceinline__ void gemm_phase(PG8_LAS unsigned char* lds, const Gemm g, const Sched& S, const Epi& E) {
    const int tid = threadIdx.x, wid = __builtin_amdgcn_readfirstlane(tid >> 6), lane = tid & 63, wr = wid >> 2, wc = wid & 3, fr = lane & 15, fq = lane >> 4;
    const int K = g.K; int nt = K / BK;
    unsigned voffA[2], voffB[2];
#pragma unroll
    for (int i = 0; i < 2; ++i) { int R, C; stage_rc(tid * 16 + i * 8192, R, C); const int Rb = Epi::PERM ? ((R & ~31) + perm32(R & 31)) : R;
        voffA[i] = (unsigned)(R * K + C) * 2u; voffB[i] = (unsigned)(Rb * K + C) * 2u; }
    const size_t kstep = (size_t)(BK * 2);
    const size_t hstep = (size_t)HALF * K * 2;
    const size_t tstep = 2 * hstep;
    const unsigned ldsw = (unsigned)wid * 1024u;
    const int aoff = lds_byte(wr * 64 + fr, fq * 8), boff = lds_byte(wc * 32 + fr, fq * 8);
#define PG8_SA(b, h) (((b) * 2 + (h)) * HTB)
#define PG8_SB(b, h) ((4 + (b) * 2 + (h)) * HTB)
#define PG8_STAGE(bufoff, gbase, voff) do { _Pragma("unroll") for (int _i = 0; _i < 2; ++_i) \
        __builtin_amdgcn_global_load_lds((const unsigned*)((const char*)(gbase) + (voff)[_i]), (PG8_LAS unsigned*)(lds + (bufoff) + ldsw + _i * 8192), 16, 0, 0); } while (0)
#define PG8_LDA(dst, b, h) do { _Pragma("unroll") for (int m = 0; m < 4; ++m) _Pragma("unroll") for (int k = 0; k < 2; ++k) dst[m][k] = *(const PG8_LAS bf16x8*)(lds + PG8_SA(b, h) + aoff + m * 2048 + k * 1024); } while (0)
#define PG8_LDB(dst, b, h) do { _Pragma("unroll") for (int n = 0; n < 2; ++n) _Pragma("unroll") for (int k = 0; k < 2; ++k) dst[n][k] = *(const PG8_LAS bf16x8*)(lds + PG8_SB(b, h) + boff + n * 2048 + k * 1024); } while (0)
#define PG8_MMA(ai, bj, At, Bt) do { __builtin_amdgcn_s_setprio(1); _Pragma("unroll") for (int m = 0; m < 4; ++m) _Pragma("unroll") for (int n = 0; n < 2; ++n) _Pragma("unroll") for (int k = 0; k < 2; ++k) \
        acc[ai][bj][m][n] = __builtin_amdgcn_mfma_f32_16x16x32_bf16(Bt[n][k], At[m][k], acc[ai][bj][m][n], 0, 0, 0); __builtin_amdgcn_s_setprio(0); } while (0)
#define PG8_WAIT_V(n) asm volatile("s_waitcnt vmcnt(" #n ")" ::: "memory")
#define PG8_WAIT_L(n) asm volatile("s_waitcnt lgkmcnt(" #n ")" ::: "memory")
#define PG8_BAR __builtin_amdgcn_s_barrier()
#define PG8_SCHED __builtin_amdgcn_sched_barrier(0)
    Unit cur, nxt; int ui = 0;
    if (!S.next(0, cur)) return;
    f32x4 acc[2][2][4][2];
#pragma unroll
    for (int a = 0; a < 2; ++a)
#pragma unroll
        for (int b = 0; b < 2; ++b)
#pragma unroll
            for (int m = 0; m < 4; ++m)
#pragma unroll
                for (int n = 0; n < 2; ++n) acc[a][b][m][n] = (f32x4){0.f, 0.f, 0.f, 0.f};
    bf16x8 At[4][2], B0[2][2], B1[2][2];
    const char* cA = (const char*)g.A + (size_t)cur.pm * tstep; const char* cB = (const char*)g.Bt + (size_t)cur.pn * tstep;
    if constexpr (Sched::SPLIT) { nt = cur.knt; cA += (size_t)cur.kt0 * kstep; cB += (size_t)cur.kt0 * kstep; }
    S.a_ready(cur);
    if constexpr (SP2) {
        PG8_STAGE(PG8_SB(0, 0), cB, voffB); PG8_STAGE(PG8_SB(0, 1), cB + hstep, voffB); PG8_STAGE(PG8_SA(0, 0), cA, voffA); PG8_STAGE(PG8_SA(0, 1), cA + hstep, voffA);
        if (wr == 1) PG8_BAR;
        PG8_WAIT_V(2); PG8_BAR;
        PG8_STAGE(PG8_SB(1, 0), cB + kstep, voffB); PG8_STAGE(PG8_SA(1, 0), cA + kstep, voffA); PG8_STAGE(PG8_SB(1, 1), cB + hstep + kstep, voffB);
        PG8_WAIT_V(6); PG8_BAR;
    } else {
        PG8_STAGE(PG8_SB(0, 0), cB, voffB); PG8_STAGE(PG8_SA(0, 0), cA, voffA); PG8_STAGE(PG8_SB(0, 1), cB + hstep, voffB); PG8_STAGE(PG8_SA(0, 1), cA + hstep, voffA);
        if (wr == 1) PG8_BAR;
        PG8_WAIT_V(4); PG8_BAR;
        PG8_STAGE(PG8_SB(1, 0), cB + kstep, voffB); PG8_STAGE(PG8_SA(1, 0), cA + kstep, voffA); PG8_STAGE(PG8_SB(1, 1), cB + hstep + kstep, voffB);
        PG8_WAIT_V(6); PG8_BAR;
    }
    for (;;) {
        const bool has_next = S.next(ui + 1, nxt);
        const char* nA = has_next ? (const char*)g.A + (size_t)nxt.pm * tstep : cA; const char* nB = has_next ? (const char*)g.Bt + (size_t)nxt.pn * tstep : cB;
        if constexpr (Sched::SPLIT) { if (has_next) { nA += (size_t)nxt.kt0 * kstep; nB += (size_t)nxt.kt0 * kstep; } }
        for (int t = 0; t < nt; t += 2) {
            const bool last = (t == nt - 2);
            const char* a1 = cA + (size_t)(t + 1) * kstep;
            const char* a2 = last ? nA : cA + (size_t)(t + 2) * kstep; const char* b2 = last ? nB : cB + (size_t)(t + 2) * kstep;
            const char* a3 = a2 + kstep; const char* b3 = b2 + kstep;
            if (last && has_next) S.a_ready(nxt);
            if constexpr (SP2) {
            PG8_LDB(B0, 0, 0); PG8_LDB(B1, 0, 1); PG8_SCHED; PG8_LDA(At, 0, 0); PG8_STAGE(PG8_SA(1, 1), a1 + hstep, voffA);
            PG8_WAIT_V(8); PG8_WAIT_L(0); PG8_BAR; PG8_MMA(0, 0, At, B0); PG8_MMA(0, 1, At, B1); PG8_BAR; PG8_SCHED;
            PG8_LDA(At, 0, 1); PG8_STAGE(PG8_SB(0, 0), b2, voffB); PG8_STAGE(PG8_SB(0, 1), b2 + hstep, voffB); PG8_STAGE(PG8_SA(0, 0), a2, voffA);
            PG8_WAIT_V(8); PG8_WAIT_L(0); PG8_BAR; PG8_MMA(1, 0, At, B0); PG8_MMA(1, 1, At, B1); PG8_BAR; PG8_SCHED;
            PG8_LDB(B0, 1, 0); PG8_LDB(B1, 1, 1); PG8_SCHED; PG8_LDA(At, 1, 0); PG8_STAGE(PG8_SA(0, 1), a2 + hstep, voffA);
            PG8_WAIT_V(8); PG8_WAIT_L(0); PG8_BAR; PG8_MMA(0, 0, At, B0); PG8_MMA(0, 1, At, B1); PG8_BAR; PG8_SCHED;
            PG8_LDA(At, 1, 1); PG8_STAGE(PG8_SB(1, 0), b3, voffB); PG8_STAGE(PG8_SB(1, 1), b3 + hstep, voffB); PG8_STAGE(PG8_SA(1, 0), a3, voffA);
            PG8_WAIT_V(8); PG8_WAIT_L(0); PG8_BAR; PG8_MMA(1, 0, At, B0); PG8_MMA(1, 1, At, B1); PG8_BAR; PG8_SCHED;
            } else {
            PG8_LDB(B0, 0, 0); PG8_SCHED; PG8_LDA(At, 0, 0); PG8_STAGE(PG8_SA(1, 1), a1 + hstep, voffA);
            PG8_WAIT_L(8); PG8_BAR; PG8_WAIT_L(0); PG8_MMA(0, 0, At, B0); PG8_BAR; PG8_SCHED;
            PG8_LDB(B1, 0, 1); PG8_STAGE(PG8_SB(0, 0), b2, voffB);
            PG8_BAR; PG8_WAIT_L(0); PG8_MMA(0, 1, At, B1); PG8_BAR;
            PG8_LDA(At, 0, 1); PG8_STAGE(PG8_SA(0, 0), a2, voffA);
            PG8_BAR; PG8_WAIT_L(0); PG8_MMA(1, 0, At, B0); PG8_BAR; PG8_SCHED;
            PG8_STAGE(PG8_SB(0, 1), b2 + hstep, voffB);
            PG8_WAIT_V(6); PG8_BAR; PG8_MMA(1, 1, At, B1); PG8_BAR;
            PG8_LDB(B0, 1, 0); PG8_SCHED; PG8_LDA(At, 1, 0); PG8_STAGE(PG8_SA(0, 1), a2 + hstep, voffA);
            PG8_WAIT_L(8); PG8_BAR; PG8_WAIT_L(0); PG8_MMA(0, 0, At, B0); PG8_BAR; PG8_SCHED;
            PG8_LDB(B1, 1, 1); PG8_STAGE(PG8_SB(1, 0), b3, voffB);
            PG8_BAR; PG8_WAIT_L(0); PG8_MMA(0, 1, At, B1); PG8_BAR;
            PG8_LDA(At, 1, 1); PG8_STAGE(PG8_SA(1, 0), a3, voffA);
            PG8_BAR; PG8_WAIT_L(0); PG8_MMA(1, 0, At, B0); PG8_BAR; PG8_SCHED;
            PG8_STAGE(PG8_SB(1, 1), b3 + hstep, voffB);
            PG8_WAIT_V(6); PG8_BAR; PG8_MMA(1, 1, At, B1); PG8_BAR;
            }
        }
        if constexpr (ALIGN_EPI) { if (wr == 0) PG8_BAR; }
        if constexpr (!Epi::AFTER_DRAIN) { E(acc, cur, wr, wc, fr, fq); S.done(cur); }
        if (!has_next) break;
#pragma unroll
        for (int a = 0; a < 2; ++a)
#pragma unroll
            for (int b = 0; b < 2; ++b)
#pragma unroll
                for (int m = 0; m < 4; ++m)
#pragma unroll
                    for (int n = 0; n < 2; ++n) acc[a][b][m][n] = (f32x4){0.f, 0.f, 0.f, 0.f};
        cur = nxt; cA = nA; cB = nB; ++ui;
        if constexpr (Sched::SPLIT) nt = cur.knt;
        if constexpr (ALIGN_EPI) { if (wr == 1) PG8_BAR; }
    }
    PG8_WAIT_V(0);
    if constexpr (!ALIGN_EPI) { if (wr == 0) PG8_BAR; }
    PG8_BAR;
    if constexpr (Epi::AFTER_DRAIN) { E.fused(acc, cur, wr, wc, fr, fq, lds, wid, lane); S.done(cur); }
#undef PG8_SA
#undef PG8_SB
#undef PG8_STAGE
#undef PG8_LDA
#undef PG8_LDB
#undef PG8_MMA
#undef PG8_WAIT_V
#undef PG8_WAIT_L
#undef PG8_BAR
#undef PG8_SCHED
}
}

namespace pg8 {
struct EpiInProj {
    static constexpr bool PERM = true, AFTER_DRAIN = false;
    unsigned char* ra;
    __device__ __forceinline__ void operator()(const f32x4 (&acc)[2][2][4][2], const Unit& u, int wr, int wc, int fr, int fq) const {
        const int pn = u.pn; bf16_t* base; int ld, coff;
        if (pn < 4) { base = (bf16_t*)(ra + RA_PZ); ld = 1024; coff = 256 * pn; }
        else if (pn < 10) { base = (bf16_t*)(ra + RA_PXBC); ld = 1536; coff = 256 * (pn - 4); }
        else if (pn < 14) { base = (bf16_t*)(ra + RA_PX0); ld = 1024; coff = 256 * (pn - 10); }
        else if (pn < 18) { base = (bf16_t*)(ra + RA_PX1); ld = 1024; coff = 256 * (pn - 14); }
        else if (pn < 22) { base = (bf16_t*)(ra + RA_PV); ld = 1024; coff = 256 * (pn - 18); }
        else { base = (bf16_t*)(ra + RA_PDT); ld = 32; coff = 0; }
        const bool dt_tile = (pn >= 22); const bool gm = (pn >= 10 && pn < 22);
        if (dt_tile && wc != 0) return;
        const int row0 = u.pm * BM + wr * 64 + fr;
#pragma unroll
        for (int ai = 0; ai < 2; ++ai)
#pragma unroll
            for (int m = 0; m < 4; ++m) {
                const int row = row0 + ai * HALF + m * 16;
#pragma unroll
                for (int bj = 0; bj < 2; ++bj) {
                    if (dt_tile && bj != 0) continue;
                    const int col = coff + bj * HALF + wc * 32 + 8 * fq;
                    bf16_t* dst = gm ? base + ((size_t)(col >> 3) * MALL + row) * 8 : base + (size_t)row * ld + col;
                    const f32x4 v0 = acc[ai][bj][m][0], v1 = acc[ai][bj][m][1];
                    u32x4 w; w.x = cvt_pk_bf16(v0[0], v0[1]); w.y = cvt_pk_bf16(v0[2], v0[3]); w.z = cvt_pk_bf16(v1[0], v1[1]); w.w = cvt_pk_bf16(v1[2], v1[3]);
                    *(u32x4*)dst = w;
                }
            }
    }
};
struct EpiQKV {
    static constexpr bool PERM = false, AFTER_DRAIN = false;
    unsigned char* ra; const float* rope; float qscale;
    __device__ __forceinline__ void operator()(const f32x4 (&acc)[2][2][4][2], const Unit& u, int wr, int wc, int fr, int fq) const {
        const int pn = u.pn; const int row0 = u.pm * BM + wr * 64 + fr;
        {
            bf16_t* base = pn < 4 ? (bf16_t*)(ra + RA_Q) + 256 * pn : (pn == 4 ? (bf16_t*)(ra + RA_K) : (bf16_t*)(ra + RA_V)); const int ld = pn < 4 ? 1024 : 256; const float sc = pn < 4 ? qscale : 1.0f;
            const bool isv = pn >= 5;
#pragma unroll
            for (int ai = 0; ai < 2; ++ai)
#pragma unroll
                for (int m = 0; m < 4; ++m) {
                    const int row = row0 + ai * HALF + m * 16; const bool lat = row < MLAT && !isv; const int t = row & (SEQ - 1);
                    const int pos = (wc & 1) ? (t & 63) : (t >> 6);
                    f32x4 cs0 = (f32x4){1.f, 0.f, 1.f, 0.f}, cs1 = cs0;
                    if (lat) { const f32x4* rp = (const f32x4*)(rope + (size_t)(pos * 16 + 4 * fq) * 2); cs0 = rp[0]; cs1 = rp[1]; }
                    bf16_t* rowp = base + (size_t)row * ld + wc * 32 + 4 * fq;
#pragma unroll
                    for (int bj = 0; bj < 2; ++bj) {
                        const f32x4 x1 = acc[ai][bj][m][0], x2 = acc[ai][bj][m][1];
                        f32x4 o1, o2;
                        o1[0] = x1[0] * cs0[0] - x2[0] * cs0[1]; o2[0] = x2[0] * cs0[0] + x1[0] * cs0[1];
                        o1[1] = x1[1] * cs0[2] - x2[1] * cs0[3]; o2[1] = x2[1] * cs0[2] + x1[1] * cs0[3];
                        o1[2] = x1[2] * cs1[0] - x2[2] * cs1[1]; o2[2] = x2[2] * cs1[0] + x1[2] * cs1[1];
                        o1[3] = x1[3] * cs1[2] - x2[3] * cs1[3]; o2[3] = x2[3] * cs1[2] + x1[3] * cs1[3];
                        o1 = o1 * sc; o2 = o2 * sc;
                        u32x2 w0, w1; w0.x = cvt_pk_bf16(o1[0], o1[1]); w0.y = cvt_pk_bf16(o1[2], o1[3]); w1.x = cvt_pk_bf16(o2[0], o2[1]); w1.y = cvt_pk_bf16(o2[2], o2[3]);
                        *(u32x2*)(rowp + bj * HALF) = w0; *(u32x2*)(rowp + bj * HALF + 16) = w1;
                    }
                }
        }
    }
};
template <bool FIRST> struct EpiResidT {
    static constexpr bool PERM = true, AFTER_DRAIN = false;
    float* xl; float* xc; const float* gate; float* slabs; const float* xl_rd; const float* xc_rd;
    __device__ __forceinline__ void operator()(const f32x4 (&acc)[2][2][4][2], const Unit& u, int wr, int wc, int fr, int fq) const {
        const int row0 = u.pm * BM + wr * 64 + fr; const int col0 = u.pn * BM + wc * 32 + 8 * fq;
        bf16_t* sl = (bf16_t*)slabs + (size_t)(u.slab < 0 ? 0 : u.slab) * (BM * BM) + (size_t)(wr * 64 + fr) * BM + wc * 32 + 8 * fq;
#pragma unroll
        for (int ai = 0; ai < 2; ++ai)
#pragma unroll
            for (int m = 0; m < 4; ++m) {
                const int row = row0 + ai * HALF + m * 16; const bool lat = row < MLAT;
                float* xrow = lat ? xl + (size_t)row * DM : xc + (size_t)(row - MLAT) * DM; const float* xrd = FIRST ? (lat ? xl_rd + (size_t)row * DM : xc_rd + (size_t)(row - MLAT) * DM) : (const float*)xrow; const float* grow = gate + (size_t)(lat ? (row >> 11) : 8) * MODW;
#pragma unroll
                for (int bj = 0; bj < 2; ++bj)
#pragma unroll
                    for (int n = 0; n < 2; ++n) { const int c = col0 + bj * HALF + n * 4;
                        const f32x4 gv = *(const f32x4*)(grow + c); const f32x4 dv = gv * acc[ai][bj][m][n];
                        if (u.slab < 0) { f32x4 xv = *(const f32x4*)(xrd + c); xv = xv + dv; *(f32x4*)(xrow + c) = xv; }
                        else { u32x2 w; w.x = cvt_pk_bf16(dv[0], dv[1]); w.y = cvt_pk_bf16(dv[2], dv[3]); *(u32x2*)(sl + (size_t)(ai * HALF + m * 16) * BM + bj * HALF + n * 4) = w; } }
            }
    }
};
struct EpiSwiGLU {
    static constexpr bool PERM = true, AFTER_DRAIN = false;
    bf16_t* act;
    __device__ __forceinline__ void operator()(const f32x4 (&acc)[2][2][4][2], const Unit& u, int wr, int wc, int fr, int fq) const {
        const int row0 = u.pm * BM + wr * 64 + fr; const int col0 = u.pn * HALF + wc * 32 + 8 * fq;
#pragma unroll
        for (int ai = 0; ai < 2; ++ai)
#pragma unroll
            for (int m = 0; m < 4; ++m) {
                float o[8];
#pragma unroll
                for (int n = 0; n < 2; ++n)
#pragma unroll
                    for (int e = 0; e < 4; ++e) { const float g = acc[ai][0][m][n][e], uu = acc[ai][1][m][n][e]; o[4 * n + e] = g * __builtin_amdgcn_rcpf(1.f + __expf(-g)) * uu; }
                u32x4 w; w.x = cvt_pk_bf16(o[0], o[1]); w.y = cvt_pk_bf16(o[2], o[3]); w.z = cvt_pk_bf16(o[4], o[5]); w.w = cvt_pk_bf16(o[6], o[7]);
                *(u32x4*)(act + (size_t)(row0 + ai * HALF + m * 16) * FFH + col0) = w;
            }
    }
};
}

struct Frame {
    LAS unsigned char* lds;
    int tid, lane, wave, G, bid;
    float* out; unsigned char* ws;
};
enum { I_X = 0, I_C, I_CTX, I_CCTX, I_ADAW, I_ADAB, I_N1G, I_N2G, I_HYINW, I_SCONVW, I_SCONVB, I_SDTB, I_SALOG, I_SD, I_SNORMG, I_HCONVW, I_HCONVB,
       I_HW1, I_HB1, I_HW2, I_HB2, I_HW3, I_HB3, I_HW4, I_HFREQ, I_HBIAS, I_HYOUTW, I_QKVW, I_SINKS, I_AOUTW, I_FFNIN, I_FFNOUT, I_FINALG };

__device__ __forceinline__ int src_col32(int kind, int n0) {
    if (kind == 0) return n0;
    if (kind == 1) { if (n0 < 2560) return n0; if (n0 < 5632) return n0 + 32; if (n0 < 5664) return n0 - 5632 + 2560; return -1; }
    const int pn = n0 >> 8, w = n0 & 255; return w < 128 ? 128 * pn + w : FFH + 128 * pn + (w - 128);
}
__device__ __forceinline__ void transpose_item(const float* W, int K, int Nsrc, bf16* WT, int kind, int nblk, LAS float* scr, int item, int lane) {
    const int kb = item / nblk, nb = item % nblk, k0 = 64 * kb, n0 = 32 * nb; const int sc0 = src_col32(kind, n0);
    float tv[32];
#pragma unroll
    for (int i = 0; i < 32; ++i) { const int kk = 2 * i + (lane >> 5); tv[i] = sc0 >= 0 ? W[(size_t)(k0 + kk) * Nsrc + sc0 + (lane & 31)] : 0.f; }
#pragma unroll
    for (int i = 0; i < 32; ++i) { const int kk = 2 * i + (lane >> 5); scr[kk * 33 + (lane & 31)] = tv[i]; }
    LDS_WAIT();
    const int c = lane & 7;
#pragma unroll
    for (int j = 0; j < 4; ++j) { const int n = (lane >> 3) + 8 * j; const LAS float* s = scr + (8 * c) * 33 + n;
        v4u o; o.x = pk2(s[0 * 33], s[1 * 33]); o.y = pk2(s[2 * 33], s[3 * 33]); o.z = pk2(s[4 * 33], s[5 * 33]); o.w = pk2(s[6 * 33], s[7 * 33]);
        *(v4u*)(WT + (size_t)(n0 + n) * K + k0 + 8 * c) = o; }
    LDS_WAIT();
}
__device__ __forceinline__ void convert_weights(Frame& F, const Args& A, int layer, int which, int b0) {
    LAS float* scr = (LAS float*)(F.lds + F.wave * 16384);
    if (F.bid < b0) return;
    const int gw = (F.bid - b0) * NWAVES + F.wave, NGW = (F.G - b0) * NWAVES; const int j = layer >> 1;
    bf16* WA = (bf16*)(F.ws + WS_WA); bf16* WB = (bf16*)(F.ws + WS_WB); bf16* WC = (bf16*)(F.ws + WS_WC); bf16* WD = (bf16*)(F.ws + WS_WD);
    const float* ffin = A.in[I_FFNIN] + (size_t)layer * DM * 2 * FFH; const float* ffout = A.in[I_FFNOUT] + (size_t)layer * FFH * DM;
    int I_A, I_B; const int I_C_ = (DM / 64) * (2 * FFH / 32), I_D_ = (FFH / 64) * (DM / 32);
    if ((layer & 1) == 0) { I_A = (DM / 64) * (INP / 32); I_B = (2048 / 64) * (DM / 32); } else { I_A = (DM / 64) * (QKV_COLS / 32); I_B = (DM / 64) * (DM / 32); }
    const int NIT = I_A + I_B + I_C_ + I_D_;
    const int it_lo = (which & 1) ? 0 : I_A + I_B, it_hi = (which & 2) ? NIT : I_A + I_B;
    for (int it = it_lo + gw; it < it_hi; it += NGW) {
        int r = it;
        if (r < I_A) { if ((layer & 1) == 0) transpose_item(A.in[I_HYINW] + (size_t)j * DM * IN_COLS, DM, IN_COLS, WA, 1, INP / 32, scr, r, F.lane);
                       else transpose_item(A.in[I_QKVW] + (size_t)j * DM * QKV_COLS, DM, QKV_COLS, WA, 0, QKV_COLS / 32, scr, r, F.lane); continue; } r -= I_A;
        if (r < I_B) { if ((layer & 1) == 0) transpose_item(A.in[I_HYOUTW] + (size_t)j * 2048 * DM, 2048, DM, WB, 0, DM / 32, scr, r, F.lane);
                       else transpose_item(A.in[I_AOUTW] + (size_t)j * DM * DM, DM, DM, WB, 0, DM / 32, scr, r, F.lane); continue; } r -= I_B;
        if (r < I_C_) { transpose_item(ffin, DM, 2 * FFH, WC, 2, 2 * FFH / 32, scr, r, F.lane); continue; } r -= I_C_;
        transpose_item(ffout, FFH, DM, WD, 0, DM / 32, scr, r, F.lane);
    }
}

__device__ __forceinline__ void copy_inputs(Frame& F, const Args& A) {
    const size_t gt = (size_t)F.bid * NTHREADS + F.tid, GT = (size_t)F.G * NTHREADS;
    if (F.G != 256) { const f32x4* cs = (const f32x4*)A.in[I_CTX]; f32x4* cd = (f32x4*)(F.ws + WS_XC); for (size_t i = gt; i < (size_t)MCTX * DM / 4; i += GT) cd[i] = cs[i]; }
    float* rope = (float*)(F.ws + WS_ROPE);
    for (size_t i = gt; i < 64 * 16; i += GT) { const int pos = (int)(i >> 4), f = (int)(i & 15); const float inv = powf(10000.0f, -(float)f / 16.0f); const float ang = (float)pos * inv;
        rope[2 * i] = cosf(ang); rope[2 * i + 1] = sinf(ang); }
}
__device__ __forceinline__ void mod_unit(Frame& F, const Args& A, int unit) {
    LAS float* sL = (LAS float*)F.lds;
    LAS float* red = (LAS float*)(F.lds + 9 * 1024 * 4);
    const int l = unit / 96, cc = unit % 96;
    for (int i = F.tid; i < 9 * 1024; i += NTHREADS) { const int r = i >> 10, k = i & 1023; const float v = r < 8 ? A.in[I_C][r * DM + k] : A.in[I_CCTX][k]; sL[i] = siluf(v); }
    __syncthreads();
    const int col = cc * 64 + (F.tid & 63), kq = F.tid >> 6;
    const float* w = A.in[I_ADAW] + (size_t)l * DM * MODW + col;
    float acc[9];
#pragma unroll
    for (int r = 0; r < 9; ++r) acc[r] = 0.f;
    for (int k0 = kq * 128; k0 < kq * 128 + 128; k0 += 16) {
        float wv[16];
#pragma unroll
        for (int i = 0; i < 16; ++i) wv[i] = w[(size_t)(k0 + i) * MODW];
#pragma unroll
        for (int i = 0; i < 16; ++i) {
#pragma unroll
            for (int r = 0; r < 9; ++r) acc[r] += sL[r * 1024 + k0 + i] * wv[i]; } }
#pragma unroll
    for (int r = 0; r < 9; ++r) red[(kq * 9 + r) * 64 + (F.tid & 63)] = acc[r];
    __syncthreads();
    float* mod = (float*)(F.ws + WS_MOD);
    for (int i = F.tid; i < 9 * 64; i += NTHREADS) { const int r = i >> 6, c = i & 63; float s = 0.f;
#pragma unroll
        for (int q = 0; q < 8; ++q) s += red[(q * 9 + r) * 64 + c];
        mod[((size_t)l * 9 + r) * MODW + cc * 64 + c] = s + A.in[I_ADAB][(size_t)l * MODW + cc * 64 + c]; }
    __syncthreads();
}
constexpr int FT = 8;
__device__ __forceinline__ void filter_unit(Frame& F, const Args& A, int unit) {
    int j, Lsel, tile; { int u = unit; j = u / 288; u %= 288; if (u < 256) { Lsel = 0; tile = u; } else { Lsel = 1; tile = u - 256; } }
    const int L = Lsel == 0 ? SEQ : CTXL; const int t0 = tile * FT;
    LAS float* zL = (LAS float*)F.lds;
    LAS float* hA = zL + FT * 36;
    LAS float* hB = hA + FT * 64;
    const float* w1 = A.in[I_HW1] + (size_t)j * 33 * 64; const float* b1 = A.in[I_HB1] + j * 64;
    const float* w2 = A.in[I_HW2] + (size_t)j * 64 * 64; const float* b2 = A.in[I_HB2] + j * 64;
    const float* w3 = A.in[I_HW3] + (size_t)j * 64 * 64; const float* b3 = A.in[I_HB3] + j * 64;
    const float* w4 = A.in[I_HW4] + (size_t)j * 64 * 2048; const float* fr = A.in[I_HFREQ] + j * 3 * 64;
    for (int i = F.tid; i < FT * 33; i += NTHREADS) { const int tt = i / 33, q = i % 33; const float t = (float)(t0 + tt);
        float v;
        if (q == 0) v = t / (float)(L - 1);
        else { const int bi = (q - 1) & 15; const float fb = 1e-4f + (float)bi * ((15.0f - 1e-4f) / 15.0f); const float ang = (6.2831855f * t) / (float)L; const float a = ang * fb; v = q <= 16 ? cosf(a) : -sinf(a); }
        zL[tt * 36 + q] = v; }
    __syncthreads();
    for (int i = F.tid; i < FT * 64; i += NTHREADS) { const int tt = i >> 6, o = i & 63; float s = b1[o];
        for (int q = 0; q < 33; ++q) s += zL[tt * 36 + q] * w1[q * 64 + o];
        hA[tt * 64 + o] = sinf(fr[o] * s); }
    __syncthreads();
    for (int i = F.tid; i < FT * 64; i += NTHREADS) { const int tt = i >> 6, o = i & 63; float s = b2[o];
        for (int q = 0; q < 64; ++q) s += hA[tt * 64 + q] * w2[q * 64 + o];
        hB[tt * 64 + o] = sinf(fr[64 + o] * s); }
    __syncthreads();
    for (int i = F.tid; i < FT * 64; i += NTHREADS) { const int tt = i >> 6, o = i & 63; float s = b3[o];
        for (int q = 0; q < 64; ++q) s += hB[tt * 64 + q] * w3[q * 64 + o];
        hA[tt * 64 + o] = sinf(fr[128 + o] * s); }
    __syncthreads();
    bf16* Fb = (bf16*)(F.ws + WS_F + (size_t)j * F_LAYER + (Lsel ? 8 * MiB : 0));
    float* SS = (float*)(F.ws + WS_CTL) + (j * 2 + Lsel) * 1024;
    const float dmin = 3.0701134573253943f, dmax = 15.350567286626972f;
    for (int q = 0; q < 4; ++q) {
        const int cp = F.tid + 512 * q; const int c = cp & 1023; const bool bwd = cp >= 1024;
        float wr[64];
#pragma unroll
        for (int i = 0; i < 64; ++i) wr[i] = w4[(size_t)i * 2048 + cp];
        const float adelta = dmin + (float)c * ((dmax - dmin) / 1023.0f);
        float ssq = 0.f;
        for (int tt = 0; tt < FT; ++tt) {
            float s = 0.f;
#pragma unroll
            for (int i4 = 0; i4 < 16; ++i4) { const f32x4 h = *(const LAS f32x4*)(hA + tt * 64 + 4 * i4); s += h[0] * wr[4 * i4] + h[1] * wr[4 * i4 + 1] + h[2] * wr[4 * i4 + 2] + h[3] * wr[4 * i4 + 3]; }
            const int t = t0 + tt; const float tu = (float)t / (float)(L - 1);
            const float val = s * __expf(-tu * adelta);
            if (!bwd) { ssq += val * val; Fb[(size_t)c * 2 * L + (L + t)] = (bf16)f2bf(val); }
            else if (t > 0) { ssq += val * val; Fb[(size_t)c * 2 * L + (L - t)] = (bf16)f2bf(val); }
        }
        atomicAdd(SS + c, ssq);
        if (tile == 0 && !bwd) Fb[(size_t)c * 2 * L] = 0;
    }
    __syncthreads();
}

__device__ __forceinline__ void nm_phase(Frame& F, const Args& A, int layer, int ks, const float* g, int M, const float* slabs, int S, const float* xl_rd, const float* xc_rd) {
    const int gw = F.bid * NWAVES + F.wave, NGW = F.G * NWAVES;
    const float* mod = (const float*)(F.ws + WS_MOD) + (size_t)layer * 9 * MODW; bf16* HN = (bf16*)(F.ws + WS_RB);
    constexpr int NR = 4;
    for (int row0 = gw; row0 < M; row0 += NR * NGW) {
        f32x4 v[NR][4];
#pragma unroll
        for (int u = 0; u < NR; ++u) { const int row = row0 + u * NGW; const int rr = row < M ? row : row0; const bool lat = rr < MLAT;
            const float* xr = lat ? xl_rd + (size_t)rr * DM : xc_rd + (size_t)(rr - MLAT) * DM;
#pragma unroll
            for (int q = 0; q < 4; ++q) v[u][q] = *(const f32x4*)(xr + 4 * F.lane + 256 * q); }
#pragma unroll
        for (int u = 0; u < NR; ++u) { const int row = row0 + u * NGW; if (row >= M) break; const bool lat = row < MLAT;
            if (slabs != nullptr && !lat) {
                const int rl = row - MLAT; const bf16* sp = (const bf16*)slabs + (size_t)((rl >> 8) * 4) * S * 65536 + (size_t)(rl & 255) * 256 + 4 * F.lane;
                for (int s = 0; s < S; ++s) {
#pragma unroll
                    for (int q = 0; q < 4; ++q) { const v2u w = *(const v2u*)(sp + ((size_t)q * S + s) * 65536); v[u][q][0] += bflo(w.x); v[u][q][1] += bfhi(w.x); v[u][q][2] += bflo(w.y); v[u][q][3] += bfhi(w.y); } }
                float* xw = (float*)(F.ws + WS_XC) + (size_t)rl * DM;
#pragma unroll
                for (int q = 0; q < 4; ++q) *(f32x4*)(xw + 4 * F.lane + 256 * q) = v[u][q]; }
            const float* mr = mod + (size_t)(lat ? (row >> 11) : 8) * MODW; float ss = 0.f;
#pragma unroll
            for (int q = 0; q < 4; ++q) ss += (v[u][q][0] * v[u][q][0] + v[u][q][1] * v[u][q][1]) + (v[u][q][2] * v[u][q][2] + v[u][q][3] * v[u][q][3]);
            const float rstd = rsqrtf(wave_sum(ss) * (1.0f / DM) + NORM_EPS);
#pragma unroll
            for (int q = 0; q < 4; ++q) { const int c = 4 * F.lane + 256 * q;
                const f32x4 gg = *(const f32x4*)(g + c), sh = *(const f32x4*)(mr + ks * DM + c), sc = *(const f32x4*)(mr + (ks + 1) * DM + c);
                const f32x4 o = v[u][q] * rstd * gg * (sc + 1.0f) + sh;
                v2u w; w.x = pk2(o[0], o[1]); w.y = pk2(o[2], o[3]); *(v2u*)(HN + (size_t)row * DM + c) = w; } }
    }
}
__device__ __forceinline__ void gate_phase(Frame& F, const Args& A, int j) {
    const int gw = F.bid * NWAVES + F.wave, NGW = F.G * NWAVES;
    const bf16* YF = (const bf16*)(F.ws + WS_RA + RA_PX1); const bf16* YB = (const bf16*)(F.ws + WS_RA + RA_PV); const bf16* PZ = (const bf16*)(F.ws + WS_RA + RA_PZ);
    bf16* CAT = (bf16*)(F.ws + WS_RB); const float* ng = A.in[I_SNORMG] + j * 1024;
    constexpr int NR = 3;
    for (int row0 = gw; row0 < MALL; row0 += NR * NGW) {
        v4u ra[NR][2], rb[NR][2], rz[NR][2];
#pragma unroll
        for (int u = 0; u < NR; ++u) { const int row = row0 + u * NGW; const int rr = row < MALL ? row : row0;
#pragma unroll
            for (int q = 0; q < 2; ++q) { const size_t off = (size_t)rr * 1024 + 8 * F.lane + 512 * q; ra[u][q] = *(const v4u*)(YF + off); rb[u][q] = *(const v4u*)(YB + off); rz[u][q] = *(const v4u*)(PZ + off); } }
#pragma unroll
        for (int u = 0; u < NR; ++u) { const int row = row0 + u * NGW; if (row >= MALL) break;
            float v[16]; float ss = 0.f;
#pragma unroll
            for (int q = 0; q < 2; ++q) {
#pragma unroll
                for (int e = 0; e < 4; ++e) { const float y0 = bflo(ra[u][q][e]) + bflo(rb[u][q][e]), y1 = bfhi(ra[u][q][e]) + bfhi(rb[u][q][e]); const float z0 = bflo(rz[u][q][e]), z1 = bfhi(rz[u][q][e]);
                    const float r0 = y0 * siluf(z0), r1 = y1 * siluf(z1); v[8 * q + 2 * e] = r0; v[8 * q + 2 * e + 1] = r1; ss += r0 * r0 + r1 * r1; } }
            const float rstd = rsqrtf(wave_sum(ss) * (1.0f / 1024.0f) + NORM_EPS);
#pragma unroll
            for (int q = 0; q < 2; ++q) { const int c = 8 * F.lane + 512 * q; const f32x4 g0 = *(const f32x4*)(ng + c), g1 = *(const f32x4*)(ng + c + 4);
                v4u w; w.x = pk2(v[8 * q] * rstd * g0[0], v[8 * q + 1] * rstd * g0[1]); w.y = pk2(v[8 * q + 2] * rstd * g0[2], v[8 * q + 3] * rstd * g0[3]);
                w.z = pk2(v[8 * q + 4] * rstd * g1[0], v[8 * q + 5] * rstd * g1[1]); w.w = pk2(v[8 * q + 6] * rstd * g1[2], v[8 * q + 7] * rstd * g1[3]);
                *(v4u*)(CAT + (size_t)row * 2048 + c) = w; } }
    }
}
__device__ __forceinline__ void final_phase(Frame& F, const Args& A) {
    const int gw = F.bid * NWAVES + F.wave, NGW = F.G * NWAVES; const float* g = A.in[I_FINALG];
    for (int row = gw; row < MLAT; row += NGW) {
        float* xr = F.out + (size_t)row * DM; f32x4 v[4]; float ss = 0.f;
#pragma unroll
        for (int q = 0; q < 4; ++q) { v[q] = *(const f32x4*)(xr + 4 * F.lane + 256 * q); ss += (v[q][0] * v[q][0] + v[q][1] * v[q][1]) + (v[q][2] * v[q][2] + v[q][3] * v[q][3]); }
        const float rstd = rsqrtf(wave_sum(ss) * (1.0f / DM) + NORM_EPS);
#pragma unroll
        for (int q = 0; q < 4; ++q) { const int c = 4 * F.lane + 256 * q; const f32x4 gg = *(const f32x4*)(g + c); *(f32x4*)(xr + c) = v[q] * rstd * gg; }
    }
}

__device__ __forceinline__ void xbcconv_unit(Frame& F, const Args& A, int unit, int j) {
    const bool isctx = unit >= 192; const int u2 = isctx ? unit - 192 : unit; const int sq = u2 / 24, sl = u2 % 24;
    const int L = isctx ? CTXL : SEQ, R = L / 64; const int rowbase = isctx ? MLAT + sq * CTXL : sq * SEQ;
    const int pc = F.tid & 7, sg = F.tid >> 3; const int ch0 = 64 * sl + 8 * pc;
    bf16* base = (bf16*)(F.ws + WS_RA + RA_PXBC) + (size_t)rowbase * 1536 + ch0;
    const float* cwp = A.in[I_SCONVW] + (size_t)j * 3 * 1536 + ch0; const float* cbp = A.in[I_SCONVB] + (size_t)j * 1536 + ch0;
    float w0[8], w1[8], w2[8], bb[8];
#pragma unroll
    for (int e = 0; e < 8; ++e) { w0[e] = cwp[e]; w1[e] = cwp[1536 + e]; w2[e] = cwp[3072 + e]; bb[e] = cbp[e]; }
    const int r0 = sg * R; const v4u z4 = (v4u){0u, 0u, 0u, 0u};
    v4u prev = r0 > 0 ? *(const v4u*)(base + (size_t)(r0 - 1) * 1536) : z4;
    v4u nextb = r0 + R < L ? *(const v4u*)(base + (size_t)(r0 + R) * 1536) : z4;
    v4u cur = *(const v4u*)(base + (size_t)r0 * 1536);
    asm volatile("s_waitcnt vmcnt(0)" : "+v"(prev), "+v"(nextb), "+v"(cur) :: "memory");
    __syncthreads();
    for (int rb = 0; rb < R; rb += 4) {
        v4u nx[4];
#pragma unroll
        for (int k = 0; k < 4; ++k) { const int r = r0 + rb + k + 1; nx[k] = (rb + k + 1 < R) ? *(const v4u*)(base + (size_t)r * 1536) : nextb; }
#pragma unroll
        for (int k = 0; k < 4; ++k) {
            float o[8];
#pragma unroll
            for (int e = 0; e < 4; ++e) {
                const float v0 = w0[2 * e] * bflo(prev[e]) + w1[2 * e] * bflo(cur[e]) + w2[2 * e] * bflo(nx[k][e]) + bb[2 * e];
                const float v1 = w0[2 * e + 1] * bfhi(prev[e]) + w1[2 * e + 1] * bfhi(cur[e]) + w2[2 * e + 1] * bfhi(nx[k][e]) + bb[2 * e + 1];
                o[2 * e] = siluf(v0); o[2 * e + 1] = siluf(v1); }
            v4u pk; pk.x = pk2(o[0], o[1]); pk.y = pk2(o[2], o[3]); pk.z = pk2(o[4], o[5]); pk.w = pk2(o[6], o[7]);
            *(v4u*)(base + (size_t)(r0 + rb + k) * 1536) = pk;
            prev = cur; cur = nx[k];
        }
    }
    __syncthreads();
}

constexpr int SSD_Q = 128, SSD_LD = 136;
__device__ __forceinline__ void ssd_unit(Frame& F, const Args& A, int unit, int j) {
    const int b = unit >> 5, h = (unit >> 1) & 15, dir = unit & 1, g = h >> 3;
    const int tid = F.tid, lane = F.lane, w = F.wave, c = lane & 31, hh = lane >> 5;
    LAS bf16* xT = (LAS bf16*)F.lds;
    LAS bf16* Bm = xT + 64 * SSD_LD;
    LAS bf16* Cm = Bm + 128 * SSD_LD;
    LAS bf16* BwT = Cm + 128 * SSD_LD;
    LAS bf16* hL = BwT + 128 * SSD_LD;
    LAS float* dtL = (LAS float*)(hL + 64 * SSD_LD);
    LAS float* acL = dtL + 128;
    LAS float* wL = acL + 128;
    LAS float* gL = wL + 128;
    const bf16* PXBC = (const bf16*)(F.ws + WS_RA + RA_PXBC); const bf16* PDT = (const bf16*)(F.ws + WS_RA + RA_PDT);
    bf16* Y = (bf16*)(F.ws + WS_RA + (dir == 0 ? RA_PX1 : RA_PV));
    const float a_neg = -expf(A.in[I_SALOG][(j * 2 + dir) * 16 + h]); const float dtb = A.in[I_SDTB][(j * 2 + dir) * 16 + h]; const float Dh = dir == 0 ? A.in[I_SD][j * 16 + h] : 0.f;
    __syncthreads();
    for (int i = tid; i < 64 * SSD_LD / 2; i += NTHREADS) ((LAS unsigned*)hL)[i] = 0u;
    f32x16 hacc;
#pragma unroll
    for (int i = 0; i < 16; ++i) hacc[i] = 0.f;
    const int I = w & 3, pt = w >> 2;
    v4u pre[10]; unsigned short predt = 0;
#define SSD_PREFETCH(qq) do { const int sg_ = (qq) < 2 ? 0 : 1, ck_ = (qq) < 2 ? (qq) : (qq) - 2; const int L_ = sg_ == 0 ? CTXL : SEQ; const int rb_ = sg_ == 0 ? MLAT + b * CTXL : b * SEQ; \
        const int t0_ = dir == 0 ? ck_ * SSD_Q : L_ - (ck_ + 1) * SSD_Q; const int tb_ = dir == 0 ? rb_ + t0_ : rb_ + t0_ + SSD_Q - 1; const int ts_ = dir == 0 ? 1 : -1; \
        _Pragma("unroll") for (int k_ = 0; k_ < 2; ++k_) { const int it_ = tid + NTHREADS * k_; pre[k_] = *(const v4u*)(PXBC + (size_t)(tb_ + ts_ * (it_ & 127)) * 1536 + 64 * h + 8 * (it_ >> 7)); } \
        _Pragma("unroll") for (int k_ = 0; k_ < 4; ++k_) { const int it_ = tid + NTHREADS * k_; const bf16* p_ = PXBC + (size_t)(tb_ + ts_ * (it_ >> 4)) * 1536 + 1024 + 128 * g + 8 * (it_ & 15); \
            pre[2 + k_] = *(const v4u*)p_; pre[6 + k_] = *(const v4u*)(p_ + 256); } \
        if (tid < SSD_Q) predt = PDT[(size_t)(tb_ + ts_ * tid) * 32 + dir * 16 + h]; } while (0)
    SSD_PREFETCH(0);
    for (int qc = 0; qc < 18; ++qc) {
        const int seg = qc < 2 ? 0 : 1, ck = qc < 2 ? qc : qc - 2;
        const int L = seg == 0 ? CTXL : SEQ; const int rowbase = seg == 0 ? MLAT + b * CTXL : b * SEQ;
        {
            const int t0 = dir == 0 ? ck * SSD_Q : L - (ck + 1) * SSD_Q;
            __syncthreads();
#pragma unroll
            for (int k = 0; k < 2; ++k) { const int it = tid + NTHREADS * k; const int tau = it & 127, pc = it >> 7;
#pragma unroll
                for (int e = 0; e < 4; ++e) { xT[(8 * pc + 2 * e) * SSD_LD + tau] = (bf16)(pre[k][e] & 0xffffu); xT[(8 * pc + 2 * e + 1) * SSD_LD + tau] = (bf16)(pre[k][e] >> 16); } }
#pragma unroll
            for (int k = 0; k < 4; ++k) { const int it = tid + NTHREADS * k; const int tau = it >> 4, pc = it & 15;
                *(LAS v4u*)(Bm + tau * SSD_LD + 8 * pc) = pre[2 + k]; *(LAS v4u*)(Cm + tau * SSD_LD + 8 * pc) = pre[6 + k]; }
            if (tid < SSD_Q) { const float xx = bf2f(predt) + dtb; const float dt = xx > 20.f ? xx : log1pf(__expf(xx));
                float sc = dt * a_neg;
#pragma unroll
                for (int o = 1; o < 64; o <<= 1) { const float up = __shfl_up(sc, o); if (lane >= o) sc += up; }
                dtL[tid] = dt; acL[tid] = sc; }
            __syncthreads();
            const float ac63 = acL[63]; const float ac_last = acL[SSD_Q - 1] + ac63;
            if (tid < SSD_Q) { const int te = tid | 31; const float mine = acL[tid] + (tid >= 64 ? ac63 : 0.f), ace = acL[te] + (te >= 64 ? ac63 : 0.f); wL[tid] = mine; gL[tid] = __expf(ace - mine) * dtL[tid]; }
            for (int it = tid; it < SSD_Q * 16; it += NTHREADS) { const int tau = it & 127, pc = it >> 7;     const float wv = __expf(ac_last - (acL[tau] + (tau >= 64 ? ac63 : 0.f))) * dtL[tau];
                const v4u bv = *(const LAS v4u*)(Bm + tau * SSD_LD + 8 * pc);
#pragma unroll
                for (int e = 0; e < 4; ++e) { BwT[(8 * pc + 2 * e) * SSD_LD + tau] = (bf16)f2bf(bflo(bv[e]) * wv); BwT[(8 * pc + 2 * e + 1) * SSD_LD + tau] = (bf16)f2bf(bfhi(bv[e]) * wv); } }
            __syncthreads();
            if (qc + 1 < 18) SSD_PREFETCH(qc + 1);
            {
                bf16x8 Cf[8], Bf[8];
#pragma unroll
                for (int s = 0; s < 8; ++s) Cf[s] = *(const LAS bf16x8*)(Cm + (32 * I + c) * SSD_LD + 16 * s + 8 * hh);
#pragma unroll
                for (int s = 0; s < 8; ++s) Bf[s] = *(const LAS bf16x8*)(Bm + c * SSD_LD + 16 * s + 8 * hh);
                const float ac_i = wL[32 * I + c];
                f32x16 yd, yo;
#pragma unroll
                for (int i = 0; i < 16; ++i) { yd[i] = 0.f; yo[i] = 0.f; }
                for (int J = 0; J <= I; ++J) {
                    const float fi = J < I ? __expf(ac_i - wL[32 * J + 31]) : 1.0f;
                    v2u xa[2], xb[2];
#pragma unroll
                    for (int s2 = 0; s2 < 2; ++s2) { const LAS bf16* xp = xT + (32 * pt + c) * SSD_LD + 32 * J + 16 * s2 + 4 * hh; xa[s2] = *(const LAS v2u*)xp; xb[s2] = *(const LAS v2u*)(xp + 8); }
                    f32x16 T;
#pragma unroll
                    for (int i = 0; i < 16; ++i) T[i] = 0.f;
                    __builtin_amdgcn_s_setprio(1);
#pragma unroll
                    for (int s = 0; s < 8; ++s) T = __builtin_amdgcn_mfma_f32_32x32x16_bf16(Bf[s], Cf[s], T, 0, 0, 0);
                    __builtin_amdgcn_s_setprio(0);
                    if (J < I) {
#pragma unroll
                        for (int s = 0; s < 8; ++s) Bf[s] = *(const LAS bf16x8*)(Bm + (32 * (J + 1) + c) * SSD_LD + 16 * s + 8 * hh);
                    } else {
#pragma unroll
                        for (int s = 0; s < 8; ++s) Bf[s] = *(const LAS bf16x8*)(hL + (32 * pt + c) * SSD_LD + 16 * s + 8 * hh);
                    }
#pragma unroll
                    for (int r = 0; r < 16; ++r) { const int jj = 32 * J + (r & 3) + 8 * (r >> 2) + 4 * hh; const float ej = J < I ? gL[jj] * fi : ((jj <= 32 * I + c) ? __expf(ac_i - wL[jj]) * dtL[jj] : 0.f); T[r] = T[r] * ej; }
#pragma unroll
                    for (int s2 = 0; s2 < 2; ++s2) {
                        v4u mf; mf.x = pk2(T[8 * s2], T[8 * s2 + 1]); mf.y = pk2(T[8 * s2 + 2], T[8 * s2 + 3]); mf.z = pk2(T[8 * s2 + 4], T[8 * s2 + 5]); mf.w = pk2(T[8 * s2 + 6], T[8 * s2 + 7]);
                        v4u xf; xf.x = xa[s2].x; xf.y = xa[s2].y; xf.z = xb[s2].x; xf.w = xb[s2].y;
                        yd = __builtin_amdgcn_mfma_f32_32x32x16_bf16(__builtin_bit_cast(bf16x8, xf), __builtin_bit_cast(bf16x8, mf), yd, 0, 0, 0);
                    }
                }
                __builtin_amdgcn_s_setprio(1);
#pragma unroll
                for (int s = 0; s < 8; ++s) yo = __builtin_amdgcn_mfma_f32_32x32x16_bf16(Bf[s], Cf[s], yo, 0, 0, 0);
                __builtin_amdgcn_s_setprio(0);
                const float ei = __expf(ac_i);
                const int ti = dir == 0 ? t0 + 32 * I + c : t0 + SSD_Q - 1 - (32 * I + c);
                bf16* yrow = Y + (size_t)(rowbase + ti) * 1024 + 64 * h + 32 * pt + 4 * hh;
#pragma unroll
                for (int q = 0; q < 4; ++q) { float yv[4];
#pragma unroll
                    for (int e = 0; e < 4; ++e) { const int r = 4 * q + e; const int p = 32 * pt + e + 8 * q + 4 * hh; yv[e] = yd[r] + ei * yo[r] + Dh * bf2f(xT[p * SSD_LD + 32 * I + c]); }
                    v2u pk; pk.x = pk2(yv[0], yv[1]); pk.y = pk2(yv[2], yv[3]); *(v2u*)(yrow + 8 * q) = pk; }
            }
            __syncthreads();
            {
                const float dec = __expf(ac_last);
#pragma unroll
                for (int i = 0; i < 16; ++i) hacc[i] *= dec;
                bf16x8 Xf[8], Wf[8];
#pragma unroll
                for (int s = 0; s < 8; ++s) { Xf[s] = *(const LAS bf16x8*)(xT + (32 * pt + c) * SSD_LD + 16 * s + 8 * hh); Wf[s] = *(const LAS bf16x8*)(BwT + (32 * I + c) * SSD_LD + 16 * s + 8 * hh); }
                __builtin_amdgcn_s_setprio(1);
#pragma unroll
                for (int s = 0; s < 8; ++s) hacc = __builtin_amdgcn_mfma_f32_32x32x16_bf16(Xf[s], Wf[s], hacc, 0, 0, 0);
                __builtin_amdgcn_s_setprio(0);
#pragma unroll
                for (int r = 0; r < 16; ++r) { const int p = 32 * pt + (r & 3) + 8 * (r >> 2) + 4 * hh; hL[p * SSD_LD + 32 * I + c] = (bf16)f2bf(hacc[r]); }
            }
        }
    }
#undef SSD_PREFETCH
    __syncthreads();
}

constexpr int HY_UB = 40, HY_CH = 128 * HY_UB;
__device__ __forceinline__ void hyena_unit(Frame& F, const Args& A, int unit, int j) {
    const bool isctx = unit >= 1024; const int cg8 = isctx ? unit - 1024 : (unit & 127); const int c0 = 8 * cg8;
    const int L = isctx ? CTXL : SEQ, nblk = isctx ? 8 : 64; const int rowbase = isctx ? MLAT : (unit >> 7) * SEQ;
    const int tid = F.tid, lane = F.lane, w = F.wave;
    LAS bf16* Ul = (LAS bf16*)F.lds + 32 * HY_UB;
    LAS bf16* Fl = (LAS bf16*)(F.lds + 81920);
    LAS float* Ys = (LAS float*)(F.lds + 81920);
    const bf16* PX0 = (const bf16*)(F.ws + WS_RA + RA_PX0) + ((size_t)cg8 * MALL + rowbase) * 8;
    const bf16* PX1 = (const bf16*)(F.ws + WS_RA + RA_PX1) + ((size_t)cg8 * MALL + rowbase) * 8;
    const bf16* PV = (const bf16*)(F.ws + WS_RA + RA_PV) + ((size_t)cg8 * MALL + rowbase) * 8;
    const bf16* Fg = (const bf16*)(F.ws + WS_F + (size_t)j * F_LAYER + (isctx ? 8 * MiB : 0)) + (size_t)c0 * 2 * L;
    const float* SS = (const float*)(F.ws + WS_CTL) + (j * 2 + (isctx ? 1 : 0)) * 1024;
    const float* hcw = A.in[I_HCONVW] + (size_t)j * 3 * 3072; const float* hcb = A.in[I_HCONVB] + (size_t)j * 3072;
    bf16* CAT = (bf16*)(F.ws + WS_RB);
    __syncthreads();
    for (int i = tid; i < 8 * 2 * 160; i += NTHREADS) { const int ch = i / 320, r = i % 320; const int side = r / 160, pz = r % 160;
        *(LAS v4u*)(Ul + ch * HY_CH + (side ? 64 : -32) * HY_UB + 8 * pz) = (v4u){0u, 0u, 0u, 0u}; }
    if (!isctx) { v4u fv[8];
#pragma unroll
        for (int k = 0; k < 8; ++k) fv[k] = *(const v4u*)(Fg + (size_t)k * 2 * SEQ + 8 * tid);
#pragma unroll
        for (int k = 0; k < 8; ++k) *(LAS v4u*)(Fl + k * 4096 + 8 * tid) = fv[k];
    } else { const int ch = tid >> 6, pz = tid & 63; *(LAS v4u*)(Fl + ch * 4096 + 8 * pz) = *(const v4u*)(Fg + (size_t)ch * 2 * CTXL + 8 * pz); }
    {
        v4u ra[4][3], rv[4][3];
#pragma unroll
        for (int q = 0; q < 4; ++q) { const int ru = tid + NTHREADS * q; const int t = ru & (L - 1); const v4u z4 = (v4u){0u, 0u, 0u, 0u};
            ra[q][0] = t > 0 ? *(const v4u*)(PX1 + (size_t)(ru - 1) * 8) : z4; ra[q][1] = *(const v4u*)(PX1 + (size_t)ru * 8); ra[q][2] = t < L - 1 ? *(const v4u*)(PX1 + (size_t)(ru + 1) * 8) : z4;
            rv[q][0] = t > 0 ? *(const v4u*)(PV + (size_t)(ru - 1) * 8) : z4; rv[q][1] = *(const v4u*)(PV + (size_t)ru * 8); rv[q][2] = t < L - 1 ? *(const v4u*)(PV + (size_t)(ru + 1) * 8) : z4; }
#pragma unroll
        for (int q = 0; q < 4; ++q) { const int ru = tid + NTHREADS * q; LAS bf16* up = Ul + (ru >> 5) * HY_UB + ((ru & 31) ^ 7);
#pragma unroll
            for (int e = 0; e < 4; ++e) {
#pragma unroll
                for (int hl = 0; hl < 2; ++hl) { const int ch = 2 * e + hl; const int c1 = 1024 + c0 + ch, c2 = 2048 + c0 + ch;
                    const float x0_ = hl ? bfhi(ra[q][0][e]) : bflo(ra[q][0][e]), x1_ = hl ? bfhi(ra[q][1][e]) : bflo(ra[q][1][e]), x2_ = hl ? bfhi(ra[q][2][e]) : bflo(ra[q][2][e]);
                    const float v0_ = hl ? bfhi(rv[q][0][e]) : bflo(rv[q][0][e]), v1_ = hl ? bfhi(rv[q][1][e]) : bflo(rv[q][1][e]), v2_ = hl ? bfhi(rv[q][2][e]) : bflo(rv[q][2][e]);
                    const float xc = hcw[c1] * x0_ + hcw[3072 + c1] * x1_ + hcw[6144 + c1] * x2_ + hcb[c1];
                    const float vc = hcw[c2] * v0_ + hcw[3072 + c2] * v1_ + hcw[6144 + c2] * v2_ + hcb[c2];
                    up[ch * (HY_CH)] = (bf16)f2bf(xc * vc); } } }
    }
    __syncthreads();
    f32x16 acc0, acc1;
#pragma unroll
    for (int i = 0; i < 16; ++i) { acc0[i] = 0.f; acc1[i] = 0.f; }
    {
        const int il = lane & 31, hh = lane >> 5;
        const LAS bf16* fw = Fl + w * 4096; const LAS bf16* uw = Ul + w * (HY_CH);
        const int I0 = il & (nblk - 1), I1 = (32 + il) & (nblk - 1);
        const bf16x8 zf = (bf16x8){0, 0, 0, 0, 0, 0, 0, 0};
        const int sh = (il + 1) & 3; const bool odw = (sh >> 1) != 0; const unsigned obit = (unsigned)(sh & 1) * 16u;
#define HY_LOAD(R0, R1, R2, B0, B1, D_, s_) do { const int al_ = L + 32 * (D_) - 16 * (s_) - 8 * hh + il - 7 - sh; \
            const LAS v2u* fp_ = (const LAS v2u*)(fw + al_); R0 = fp_[0]; R1 = fp_[1]; R2 = fp_[2]; \
            if (isctx) { const int J0_ = I0 - (D_), J1_ = I1 - (D_); B0 = zf; B1 = zf; \
                if (J0_ >= 0 && J0_ < nblk) B0 = *(const LAS bf16x8*)(uw + (il - (D_)) * HY_UB + 16 * (s_) + 8 * hh); \
                if (J1_ >= 0 && J1_ < nblk) B1 = *(const LAS bf16x8*)(uw + (32 + il - (D_)) * HY_UB + 16 * (s_) + 8 * hh); } \
            else { B0 = *(const LAS bf16x8*)(uw + (il - (D_)) * HY_UB + 16 * (s_) + 8 * hh); B1 = *(const LAS bf16x8*)(uw + (32 + il - (D_)) * HY_UB + 16 * (s_) + 8 * hh); } } while (0)
#define HY_FIX(AF, R0, R1, R2) do { \
            const unsigned s0_ = odw ? R0.y : R0.x, s1_ = odw ? R1.x : R0.y, s2_ = odw ? R1.y : R1.x, s3_ = odw ? R2.x : R1.y, s4_ = odw ? R2.y : R2.x; \
            v4u af_; af_.x = __builtin_amdgcn_alignbit(s1_, s0_, obit); af_.y = __builtin_amdgcn_alignbit(s2_, s1_, obit); af_.z = __builtin_amdgcn_alignbit(s3_, s2_, obit); af_.w = __builtin_amdgcn_alignbit(s4_, s3_, obit); \
            AF = __builtin_bit_cast(bf16x8, af_); } while (0)
        bf16x8 a0, b00, b01, a1, b10, b11; v2u p0, p1, p2, q0, q1, q2;
        const int Dlo = -(nblk - 1), Dhi = nblk - 1;
        HY_LOAD(p0, p1, p2, b00, b01, Dlo, 0);
#define HY_BODY(T0, T1) { \
            HY_LOAD(q0, q1, q2, b10, b11, D, 1);                                     \
            HY_FIX(a0, p0, p1, p2); \
            __builtin_amdgcn_s_setprio(1); \
            if (T0) acc0 = __builtin_amdgcn_mfma_f32_32x32x16_bf16(a0, b00, acc0, 0, 0, 0); \
            if (T1) acc1 = __builtin_amdgcn_mfma_f32_32x32x16_bf16(a0, b01, acc1, 0, 0, 0); \
            __builtin_amdgcn_s_setprio(0); \
            bf16x8 n00, n01; const int Dn = D < Dhi ? D + 1 : Dhi;                    \
            HY_LOAD(p0, p1, p2, n00, n01, Dn, 0);                                    \
            HY_FIX(a1, q0, q1, q2); \
            __builtin_amdgcn_s_setprio(1); \
            if (T0) acc0 = __builtin_amdgcn_mfma_f32_32x32x16_bf16(a1, b10, acc0, 0, 0, 0); \
            if (T1) acc1 = __builtin_amdgcn_mfma_f32_32x32x16_bf16(a1, b11, acc1, 0, 0, 0); \
            __builtin_amdgcn_s_setprio(0); \
            b00 = n00; b01 = n01; }
        {
            if (isctx) { for (int D = Dlo; D <= Dhi; ++D) HY_BODY(1, 1) }
            else { for (int D = Dlo; D <= -32; ++D) HY_BODY(1, 0)
                   for (int D = -31; D <= 31; ++D) HY_BODY(1, 1)
                   for (int D = 32; D <= Dhi; ++D) HY_BODY(0, 1) }
        }
#undef HY_BODY
#undef HY_FIX
#undef HY_LOAD
    }
    __syncthreads();
    {
        const int il = lane & 31, hh = lane >> 5; LAS float* yw = Ys + w * (64 * 33);
#pragma unroll
        for (int r = 0; r < 16; ++r) { const int irow = (r & 3) + 8 * (r >> 2) + 4 * hh; yw[33 * il + irow] = acc0[r]; yw[33 * (32 + il) + irow] = acc1[r]; }
    }
    __syncthreads();
    {
        v4u rx[4][3];
#pragma unroll
        for (int q = 0; q < 4; ++q) { const int ru = tid + NTHREADS * q; const int t = ru & (L - 1); const v4u z4 = (v4u){0u, 0u, 0u, 0u};
            rx[q][0] = t > 0 ? *(const v4u*)(PX0 + (size_t)(ru - 1) * 8) : z4; rx[q][1] = *(const v4u*)(PX0 + (size_t)ru * 8); rx[q][2] = t < L - 1 ? *(const v4u*)(PX0 + (size_t)(ru + 1) * 8) : z4; }
#pragma unroll
        for (int q = 0; q < 4; ++q) { const int ru = tid + NTHREADS * q; const size_t m = (size_t)(rowbase + ru);
            const LAS bf16* up = Ul + (ru >> 5) * HY_UB + ((ru & 31) ^ 7);     const LAS float* yp = Ys + 33 * (ru >> 5) + (ru & 31);
            float o[8];
#pragma unroll
            for (int e = 0; e < 4; ++e) {
#pragma unroll
                for (int hl = 0; hl < 2; ++hl) { const int ch = 2 * e + hl; const int cc = c0 + ch;
                    const float x0_ = hl ? bfhi(rx[q][0][e]) : bflo(rx[q][0][e]), x1_ = hl ? bfhi(rx[q][1][e]) : bflo(rx[q][1][e]), x2_ = hl ? bfhi(rx[q][2][e]) : bflo(rx[q][2][e]);
                    const float xc = hcw[cc] * x0_ + hcw[3072 + cc] * x1_ + hcw[6144 + cc] * x2_ + hcb[cc];
                    const float uu = bf2f(up[ch * (HY_CH)]); const float yv = yp[ch * (64 * 33)];
                    const float sc = rsqrtf(SS[cc] + 1e-6f);
                    o[ch] = xc * (sc * yv + A.in[I_HBIAS][j * 1024 + cc] * uu); } }
            v4u wv; wv.x = pk2(o[0], o[1]); wv.y = pk2(o[2], o[3]); wv.z = pk2(o[4], o[5]); wv.w = pk2(o[6], o[7]);
            *(v4u*)(CAT + m * 2048 + 1024 + c0) = wv; }
    }
    __syncthreads();
}

constexpr int AT_LD = 72;
__device__ __forceinline__ void attn_unit(Frame& F, const Args& A, int unit, int jl) {
    const bool isctx = unit >= 1024; int b, g, qb;
    if (!isctx) { b = unit >> 7; g = (unit >> 5) & 3; qb = unit & 31; } else { const int u2 = unit - 1024; b = u2 >> 4; g = (u2 >> 2) & 3; qb = u2 & 3; }
    const int tid = F.tid, lane = F.lane, w = F.wave, l15 = lane & 15, l4 = lane >> 4;
    const int hq = 4 * g + (w >> 1); const int qoff = qb * 64 + (w & 1) * 32;
    const int qrow0 = (isctx ? MLAT + b * CTXL : b * SEQ) + qoff;
    const bf16* Q = (const bf16*)(F.ws + WS_RA + RA_Q); const bf16* K = (const bf16*)(F.ws + WS_RA + RA_K); const bf16* V = (const bf16*)(F.ws + WS_RA + RA_V);
    bf16* O = (bf16*)(F.ws + WS_RB + SZ_M1024);
    LAS bf16* Kl = (LAS bf16*)F.lds;
    LAS bf16* Vl = Kl + 4 * 64 * AT_LD;
    const int l31 = lane & 31, hh = lane >> 5;
    bf16x8 Qf[4];
#pragma unroll
    for (int ks = 0; ks < 4; ++ks) Qf[ks] = *(const bf16x8*)(Q + (size_t)(qrow0 + l31) * 1024 + hq * 64 + 16 * ks + 8 * hh);
    float mrow = -1e30f, lrow = 0.f; f32x16 Oa[2];
#pragma unroll
    for (int i = 0; i < 16; ++i) { Oa[0][i] = 0.f; Oa[1][i] = 0.f; }
    const int c_lo = isctx ? 0 : ((qb * 64 - 128) < 0 ? (128 - qb * 64) / 64 : 0);
    const int c_hi = isctx ? -1 : ((qb * 64 + 128 + 64) > SEQ ? 4 - (qb * 64 + 192 - SEQ) / 64 : 4);
    const int nck = 4 + (isctx ? 0 : (c_hi - c_lo + 1));
    const int kr = tid & 63, kp = tid >> 6;
#define AT_ROW0(ck_) ((ck_) < 4 ? MLAT + b * CTXL + 64 * (ck_) : b * SEQ + qb * 64 - 128 + 64 * ((ck_) - 4 + c_lo))
    v4u pkA, pvA, pkB, pvB;
    { const size_t r = (size_t)(AT_ROW0(0) + kr) * 256 + g * 64 + 8 * kp; pkA = *(const v4u*)(K + r); pvA = *(const v4u*)(V + r); }
    { const size_t r = (size_t)(AT_ROW0(1) + kr) * 256 + g * 64 + 8 * kp; pkB = *(const v4u*)(K + r); pvB = *(const v4u*)(V + r); }
    __syncthreads();
#define AT_COMPUTE(BUFO) { const int bufo = (BUFO); \
        const int cw_ = ck - 4 + c_lo; const bool masked = ck >= 4 && (cw_ == 0 || cw_ == 4); const int kc0 = qb * 64 - 128 + 64 * cw_;    \
        f32x16 St[2]; \
        _Pragma("unroll") \
        for (int kt = 0; kt < 2; ++kt) { \
        _Pragma("unroll") \
            for (int i = 0; i < 16; ++i) St[kt][i] = 0.f; \
        _Pragma("unroll") \
            for (int ks = 0; ks < 4; ++ks) { const bf16x8 kf = *(const LAS bf16x8*)(Kl + bufo + (32 * kt + l31) * AT_LD + 16 * ks + 8 * hh); \
                St[kt] = __builtin_amdgcn_mfma_f32_32x32x16_bf16(kf, Qf[ks], St[kt], 0, 0, 0); } } \
        if (masked) { const int qi = qoff + l31; \
        _Pragma("unroll") \
            for (int kt = 0; kt < 2; ++kt) \
        _Pragma("unroll") \
                for (int r = 0; r < 16; ++r) { const int kj = kc0 + 32 * kt + (r & 3) + 8 * (r >> 2) + 4 * hh; const int d = qi - kj; if (d > 128 || d < -128) St[kt][r] = -1e30f; } } \
        float mx = St[0][0]; \
        _Pragma("unroll") \
        for (int r = 1; r < 16; ++r) mx = fmaxf(mx, St[0][r]); \
        _Pragma("unroll") \
        for (int r = 0; r < 16; ++r) mx = fmaxf(mx, St[1][r]); \
        mx = fmaxf(mx, __shfl_xor(mx, 32)); \
        const float mn = fmaxf(mrow, mx); const float alpha = __builtin_amdgcn_exp2f(mrow - mn); mrow = mn; \
        float ps = 0.f; \
        _Pragma("unroll") \
        for (int kt = 0; kt < 2; ++kt) \
        _Pragma("unroll") \
            for (int r = 0; r < 16; ++r) { const float pv = __builtin_amdgcn_exp2f(St[kt][r] - mn); St[kt][r] = pv; ps += pv; } \
        lrow = lrow * alpha + ps; \
        _Pragma("unroll") \
        for (int i = 0; i < 16; ++i) { Oa[0][i] *= alpha; Oa[1][i] *= alpha; } \
        _Pragma("unroll") \
        for (int kt = 0; kt < 2; ++kt) \
        _Pragma("unroll") \
            for (int s2 = 0; s2 < 2; ++s2) { \
                v4u pf; pf.x = pk2(St[kt][8 * s2], St[kt][8 * s2 + 1]); pf.y = pk2(St[kt][8 * s2 + 2], St[kt][8 * s2 + 3]); pf.z = pk2(St[kt][8 * s2 + 4], St[kt][8 * s2 + 5]); pf.w = pk2(St[kt][8 * s2 + 6], St[kt][8 * s2 + 7]); \
        _Pragma("unroll") \
                for (int dt = 0; dt < 2; ++dt) { const LAS bf16* vp = Vl + bufo + (32 * dt + l31) * AT_LD + 32 * kt + 16 * s2 + 4 * hh; \
                    const v2u va = *(const LAS v2u*)vp, vb = *(const LAS v2u*)(vp + 8); \
                    v4u vf; vf.x = va.x; vf.y = va.y; vf.z = vb.x; vf.w = vb.y; \
                    Oa[dt] = __builtin_amdgcn_mfma_f32_32x32x16_bf16(__builtin_bit_cast(bf16x8, vf), __builtin_bit_cast(bf16x8, pf), Oa[dt], 0, 0, 0); } \
            } \
     \
    }
#define AT_STAGE(PK, PV, BUFO) { const int bo_ = (BUFO); *(LAS v4u*)(Kl + bo_ + kr * AT_LD + 8 * kp) = PK; \
        _Pragma("unroll") for (int e = 0; e < 4; ++e) { Vl[bo_ + (8 * kp + 2 * e) * AT_LD + kr] = (bf16)(PV[e] & 0xffffu); Vl[bo_ + (8 * kp + 2 * e + 1) * AT_LD + kr] = (bf16)(PV[e] >> 16); } \
        __syncthreads(); \
        if (ck + 2 < nck) { const size_t r = (size_t)(AT_ROW0(ck + 2) + kr) * 256 + g * 64 + 8 * kp; PK = *(const v4u*)(K + r); PV = *(const v4u*)(V + r); } }
    for (int ck = 0; ck < nck; ck += 2) {
        AT_STAGE(pkA, pvA, 0) AT_COMPUTE(0)
        if (ck + 1 < nck) { ++ck; AT_STAGE(pkB, pvB, 64 * AT_LD) AT_COMPUTE(64 * AT_LD) --ck; }
    }
#undef AT_STAGE
#undef AT_COMPUTE
#undef AT_ROW0
    const float sink2 = A.in[I_SINKS][jl * 16 + hq] * 1.4426950408889634f;
    const float ltot = lrow + __shfl_xor(lrow, 32);
    const float inv = 1.0f / (ltot + exp2f(sink2 - mrow));
    bf16* orow = O + (size_t)(qrow0 + l31) * 1024 + hq * 64 + 4 * hh;
#pragma unroll
    for (int dt = 0; dt < 2; ++dt)
#pragma unroll
        for (int q4 = 0; q4 < 4; ++q4) { v2u pk; pk.x = pk2(Oa[dt][4 * q4] * inv, Oa[dt][4 * q4 + 1] * inv); pk.y = pk2(Oa[dt][4 * q4 + 2] * inv, Oa[dt][4 * q4 + 3] * inv);
            *(v2u*)(orow + 32 * dt + 8 * q4) = pk; }
}

constexpr int LDS_BYTES = 155648;
constexpr int NPHASE = 2 + 2 * 9 + 2 * 7;

#ifndef REP_GEMM
#define REP_GEMM 1
#endif
#ifndef REP_E3
#define REP_E3 1
#endif
#ifndef REP_ATT
#define REP_ATT 1
#endif
#ifndef REP_NM
#define REP_NM 1
#endif
#ifndef REP_P0
#define REP_P0 1
#endif
#ifndef REP_SYNC
#define REP_SYNC 1
#endif
#define PHASE_BEGIN if (ph >= lo && ph < hi) {
#define PHASE_END   if (ph + 1 < hi) { if (ph == lo) cg::this_grid().sync(); else xcd_barrier(bar); } } ++ph;
template <int layer> __device__ __forceinline__ void layer_body(Frame& F, const Args& A, const XcdBarrier& bar, int& ph, const int lo, const int hi) {
    constexpr int j = layer >> 1; constexpr bool need_ctx = layer < DEPTH - 1; constexpr int Mrows = need_ctx ? MALL : MLAT;

        const float* modl = (const float*)(F.ws + WS_MOD) + (size_t)layer * 9 * MODW;
        if constexpr ((layer & 1) == 0) {
            PHASE_BEGIN
                pg8::Gemm g{(const pg8::bf16_t*)(F.ws + WS_RB), (const pg8::bf16_t*)(F.ws + WS_WA), MALL, INP, DM}; pg8::StaticOrder S; S.init(MALL, INP, F.G, F.bid);
                pg8::EpiInProj E{F.ws + WS_RA};
                for (int rep_ = 0; rep_ < REP_GEMM; ++rep_) { pg8::gemm_phase<pg8::EpiInProj, pg8::StaticOrder, true, true>(F.lds, g, S, E); }
            PHASE_END
            PHASE_BEGIN
                for (int u = F.bid; u < 1152; u += F.G) hyena_unit(F, A, u, j);
                for (int u = F.G - 1 - F.bid; u < 384; u += F.G) xbcconv_unit(F, A, u, j);
            PHASE_END
            PHASE_BEGIN
                for (int u = F.bid; u < 256; u += F.G) ssd_unit(F, A, u, j);
            PHASE_END
            PHASE_BEGIN
                for (int rep_ = 0; rep_ < REP_NM; ++rep_) gate_phase(F, A, j);
            PHASE_END
            PHASE_BEGIN
                pg8::Gemm g{(const pg8::bf16_t*)(F.ws + WS_RB), (const pg8::bf16_t*)(F.ws + WS_WB), MALL, DM, 2048}; pg8::SplitOrder S; S.init(MALL, DM, 2048, F.G, F.bid, F.G == 256 ? 8 : 1);
                pg8::EpiResidT<layer == 0> E{F.out, (float*)(F.ws + WS_XC), modl + 2 * DM, (float*)(F.ws + WS_RA), A.in[I_X], A.in[I_CTX]};
                pg8::gemm_phase<pg8::EpiResidT<layer == 0>, pg8::SplitOrder, true, true>(F.lds, g, S, E);
            PHASE_END
        } else {
            PHASE_BEGIN
                pg8::Gemm g{(const pg8::bf16_t*)(F.ws + WS_RB), (const pg8::bf16_t*)(F.ws + WS_WA), MALL, QKV_COLS, DM}; pg8::StaticOrder S; S.init(MALL, QKV_COLS, F.G, F.bid);
                pg8::EpiQKV E{F.ws + WS_RA, (const float*)(F.ws + WS_ROPE), 0.125f * 1.4426950408889634f};
                for (int rep_ = 0; rep_ < REP_GEMM; ++rep_) { pg8::gemm_phase<pg8::EpiQKV, pg8::StaticOrder, true, true>(F.lds, g, S, E); }
            PHASE_END
            PHASE_BEGIN
                const int nu = need_ctx ? 1152 : 1024;
#ifndef NO_ATTN
                for (int u = F.bid; u < nu; u += F.G) attn_unit(F, A, u, j);
#endif
            PHASE_END
            PHASE_BEGIN
                pg8::Gemm g{(const pg8::bf16_t*)(F.ws + WS_RB + SZ_M1024), (const pg8::bf16_t*)(F.ws + WS_WB), Mrows, DM, DM}; pg8::SplitOrder S; S.init(Mrows, DM, DM, F.G, F.bid, F.G == 256 ? 8 : 1);
                pg8::EpiResidT<false> E{F.out, (float*)(F.ws + WS_XC), modl + 2 * DM, (float*)(F.ws + WS_RA), nullptr, nullptr};
                pg8::gemm_phase<pg8::EpiResidT<false>, pg8::SplitOrder, true, true>(F.lds, g, S, E);
            PHASE_END
        }
        PHASE_BEGIN
            for (int rep_ = 0; rep_ < REP_NM; ++rep_) nm_phase(F, A, layer, 3, A.in[I_N2G] + layer * DM, Mrows, (need_ctx && F.G == 256) ? (const float*)(F.ws + WS_RA) : nullptr, 8, (const float*)F.out, (layer == 0 && F.G == 256) ? A.in[I_CTX] : (const float*)(F.ws + WS_XC));
        PHASE_END
        PHASE_BEGIN
            pg8::Gemm g{(const pg8::bf16_t*)(F.ws + WS_RB), (const pg8::bf16_t*)(F.ws + WS_WC), Mrows, 2 * FFH, DM}; pg8::StaticOrder S; S.init(Mrows, 2 * FFH, F.G, F.bid);
            pg8::EpiSwiGLU E{(pg8::bf16_t*)(F.ws + WS_RA)};
            for (int rep_ = 0; rep_ < REP_GEMM; ++rep_) { pg8::gemm_phase<pg8::EpiSwiGLU, pg8::StaticOrder, true, true>(F.lds, g, S, E); }
            if (layer + 1 < DEPTH) { const int tail = S.nwg % F.G; __syncthreads(); convert_weights(F, A, layer + 1, 1, tail < F.G / 2 ? tail : 0); }
        PHASE_END
        PHASE_BEGIN
            pg8::Gemm g{(const pg8::bf16_t*)(F.ws + WS_RA), (const pg8::bf16_t*)(F.ws + WS_WD), Mrows, DM, FFH}; pg8::SplitOrder S; S.init(Mrows, DM, FFH, F.G, F.bid, F.G == 256 ? 2 : 1);
            pg8::EpiResidT<false> E{F.out, (float*)(F.ws + WS_XC), modl + 5 * DM, (float*)(F.ws + WS_RB + 40 * MiB), nullptr, nullptr};
            pg8::gemm_phase<pg8::EpiResidT<false>, pg8::SplitOrder, true, true>(F.lds, g, S, E);
        PHASE_END
        PHASE_BEGIN
            if (layer + 1 < DEPTH) { convert_weights(F, A, layer + 1, 2, 0); nm_phase(F, A, layer + 1, 0, A.in[I_N1G] + (layer + 1) * DM, MALL, (need_ctx && F.G == 256) ? (const float*)(F.ws + WS_RB + 40 * MiB) : nullptr, 2, (const float*)F.out, (const float*)(F.ws + WS_XC)); }
            else final_phase(F, A);
        PHASE_END
    }
#undef PHASE_BEGIN
#undef PHASE_END

__global__ void __launch_bounds__(NTHREADS, 2) fwd_kernel(Args A) {
    extern __shared__ __attribute__((aligned(16))) unsigned char lds_raw[];
    Frame F;
    F.lds = (LAS unsigned char*)lds_raw;
    F.tid = threadIdx.x; F.lane = F.tid & 63; F.wave = __builtin_amdgcn_readfirstlane(F.tid >> 6); F.G = gridDim.x; F.bid = blockIdx.x;
    F.out = A.out; F.ws = A.ws;
    const int lo = A.ph_lo, hi = A.ph_hi;
    int ph = 0;
    volatile LAS unsigned* bst = (volatile LAS unsigned*)(F.lds + LDS_BYTES - 64);
    if (F.tid < 2) bst[F.tid] = 0u;
    __syncthreads();
    XcdBarrier bar; bar.bar = (unsigned*)(F.ws + WS_CTL + 32768); bar.x = 0; bar.st = bst;
    if (hi - lo > 1) bar = xcd_barrier_post((unsigned*)(F.ws + WS_CTL + 32768), bst);
#define PHASE_BEGIN if (ph >= lo && ph < hi) {
#define PHASE_END   if (ph + 1 < hi) { if (ph == lo) cg::this_grid().sync(); else xcd_barrier(bar); } } ++ph;

    PHASE_BEGIN
#ifndef NO_P0
        for (int rep_ = 0; rep_ < REP_P0; ++rep_) {
        for (int u = F.bid; u < 576; u += F.G) filter_unit(F, A, u);
        for (int u = F.bid; u < 384; u += F.G) mod_unit(F, A, u);
        copy_inputs(F, A);
        convert_weights(F, A, 0, 3, 0);
        }
#endif
    PHASE_END
    PHASE_BEGIN
        nm_phase(F, A, 0, 0, A.in[I_N1G], MALL, nullptr, 1, A.in[I_X], A.in[I_CTX]);
    PHASE_END

    layer_body<0>(F, A, bar, ph, lo, hi);
    layer_body<1>(F, A, bar, ph, lo, hi);
    layer_body<2>(F, A, bar, ph, lo, hi);
    layer_body<3>(F, A, bar, ph, lo, hi);
#undef PHASE_BEGIN
#undef PHASE_END
}

extern "C" void kernel_launch(void* const* d_in, const int* in_sizes, int n_in, void* d_out, int out_size, void* d_ws, size_t ws_size, hipStream_t stream) {
    static int grid = 0;
    if (grid == 0) {
        if (n_in != 33 || out_size != MLAT * DM || ws_size < WS_END) { fprintf(stderr, "kernel_launch: unexpected shapes (n_in %d out %d ws %zu)\n", n_in, out_size, ws_size); grid = -1; return; }
        int dev = 0, cus = 0, per_cu = 0;
        if (hipGetDevice(&dev) != hipSuccess || hipDeviceGetAttribute(&cus, hipDeviceAttributeMultiprocessorCount, dev) != hipSuccess) { grid = -1; return; }
        if (hipFuncSetAttribute((const void*)fwd_kernel, hipFuncAttributeMaxDynamicSharedMemorySize, LDS_BYTES) != hipSuccess) { fprintf(stderr, "kernel_launch: hipFuncSetAttribute failed\n"); grid = -1; return; }
        if (hipOccupancyMaxActiveBlocksPerMultiprocessor(&per_cu, (const void*)fwd_kernel, NTHREADS, LDS_BYTES) != hipSuccess || per_cu < 1) { fprintf(stderr, "kernel_launch: occupancy query failed (%d)\n", per_cu); (void)hipGetLastError(); per_cu = 1; }
        grid = cus;
        if (grid > 256) grid = 256;
    }
    if (grid < 0) return;
    (void)hipMemsetAsync((char*)d_ws + WS_CTL, 0, CTL_BYTES, stream);
    Args a{};
    for (int i = 0; i < 33; ++i) a.in[i] = (const float*)d_in[i];
    a.out = (float*)d_out; a.ws = (unsigned char*)d_ws;
#ifndef N_LAUNCH_PER_PHASE
#define N_LAUNCH_PER_PHASE 0
#endif
#if N_LAUNCH_PER_PHASE
#ifndef PROBE_MASK
#define PROBE_MASK 0u
#endif
#ifndef PROBE_DRY
#define PROBE_DRY 1
#endif
#ifndef PROBE_REPS
#define PROBE_REPS 2
#endif
    for (int p = 0; p < NPHASE; ++p) {
        const int reps = ((PROBE_MASK >> p) & 1u) ? PROBE_REPS : 1;
        for (int r = 0; r < reps; ++r) {
            a.ph_lo = p; a.ph_hi = p + 1; a.dry = (r + 1 < reps) ? PROBE_DRY : 0;
            void* kargs[] = {&a};
            hipError_t e = hipLaunchCooperativeKernel((const void*)fwd_kernel, dim3(grid), dim3(NTHREADS), kargs, LDS_BYTES, stream);
            if (e != hipSuccess) { fprintf(stderr, "kernel_launch: launch %d failed: %s\n", p, hipGetErrorString(e)); break; }
        }
    }
#else
    a.ph_lo = 0; a.ph_hi = NPHASE;
    void* kargs[] = {&a};
    hipError_t e = hipLaunchCooperativeKernel((const void*)fwd_kernel, dim3(grid), dim3(NTHREADS), kargs, LDS_BYTES, stream);
    if (e != hipSuccess) fprintf(stderr, "kernel_launch: cooperative launch failed: %s (grid %d)\n", hipGetErrorString(e), grid);
#endif
}
```

```cpp
#include <hip/hip_runtime.h>
#include <hip/hip_cooperative_groups.h>
#include <cstdio>
#include <cstdint>
namespace cg = cooperative_groups;

#define LAS __attribute__((address_space(3)))
typedef unsigned short bf16;
typedef unsigned v4u __attribute__((ext_vector_type(4)));
typedef unsigned v2u __attribute__((ext_vector_type(2)));
typedef float f32x4 __attribute__((ext_vector_type(4)));
typedef float f32x16 __attribute__((ext_vector_type(16)));
typedef short bf16x8 __attribute__((ext_vector_type(8)));

constexpr int DM = 1024, NBATCH = 8, SEQ = 2048, CTXL = 256, DEPTH = 4;
constexpr int MLAT = NBATCH * SEQ, MCTX = NBATCH * CTXL, MALL = MLAT + MCTX;
constexpr int NMOD = 6, MODW = NMOD * DM;
constexpr int FFH = 2816;
constexpr int IN_COLS = 5664, INP = 5888;
constexpr int QKV_COLS = 1536;
constexpr float NORM_EPS = 1e-6f;
constexpr int NWAVES = 8, NTHREADS = 512;

constexpr size_t MiB = 1u << 20;
constexpr size_t WS_CTL = 0, CTL_BYTES = 64 * 1024;
constexpr size_t WS_MOD = 1 * MiB;
constexpr size_t WS_ROPE = 2 * MiB;
constexpr size_t WS_F = 3 * MiB;
constexpr size_t F_LAYER = 9 * MiB;
constexpr size_t WS_XC = 21 * MiB;
constexpr size_t WS_WA = 29 * MiB;
constexpr size_t WS_WB = 41 * MiB;
constexpr size_t WS_WC = 45 * MiB;
constexpr size_t WS_WD = 56 * MiB;
constexpr size_t WS_RA = 62 * MiB;
constexpr size_t RA_BYTES = 200 * MiB;
constexpr size_t WS_RB = WS_RA + RA_BYTES;
constexpr size_t RB_BYTES = 72 * MiB;
constexpr size_t WS_Y = WS_RB + RB_BYTES;
constexpr size_t WS_END = WS_Y + 36 * MiB;
constexpr size_t SZ_M1024 = (size_t)MALL * 1024 * 2;
constexpr size_t RA_PZ = 0, RA_PXBC = RA_PZ + SZ_M1024, RA_PX0 = RA_PXBC + (size_t)MALL * 1536 * 2, RA_PX1 = RA_PX0 + SZ_M1024, RA_PV = RA_PX1 + SZ_M1024, RA_PDT = RA_PV + SZ_M1024;
static_assert(RA_PDT + (size_t)MALL * 32 * 2 <= RA_BYTES, "region A (even)");
constexpr size_t RA_Q = 0, RA_K = RA_Q + SZ_M1024, RA_V = RA_K + (size_t)MALL * 256 * 2;
static_assert((size_t)MALL * FFH * 2 <= RA_BYTES, "region A (ffn)");
static_assert(2 * SZ_M1024 <= RB_BYTES, "region B");

typedef float f32x2_t __attribute__((ext_vector_type(2))); typedef __bf16 bf16x2_t __attribute__((ext_vector_type(2)));
__device__ __forceinline__ unsigned pk2(float lo, float hi) { f32x2_t v = {lo, hi}; bf16x2_t b = __builtin_convertvector(v, bf16x2_t); return __builtin_bit_cast(unsigned, b); }
__device__ __forceinline__ unsigned f2bf(float f) { return pk2(f, 0.f) & 0xffffu; }
__device__ __forceinline__ float bf2f(unsigned short h) { return __builtin_bit_cast(float, (unsigned)h << 16); }
__device__ __forceinline__ float bflo(unsigned w) { return __builtin_bit_cast(float, w << 16); }
__device__ __forceinline__ float bfhi(unsigned w) { return __builtin_bit_cast(float, w & 0xffff0000u); }
__device__ __forceinline__ float siluf(float x) { return x * __builtin_amdgcn_rcpf(1.f + __expf(-x)); }
__device__ __forceinline__ float wave_sum(float v) {
    v += __builtin_bit_cast(float, __builtin_amdgcn_update_dpp(0, __builtin_bit_cast(int, v), 0xB1, 0xf, 0xf, false));
    v += __builtin_bit_cast(float, __builtin_amdgcn_update_dpp(0, __builtin_bit_cast(int, v), 0x4E, 0xf, 0xf, false));
    v += __builtin_bit_cast(float, __builtin_amdgcn_update_dpp(0, __builtin_bit_cast(int, v), 0x141, 0xf, 0xf, false));
    v += __builtin_bit_cast(float, __builtin_amdgcn_update_dpp(0, __builtin_bit_cast(int, v), 0x140, 0xf, 0xf, false));
    const float s0 = __builtin_bit_cast(float, __builtin_amdgcn_readlane(__builtin_bit_cast(int, v), 0)), s1 = __builtin_bit_cast(float, __builtin_amdgcn_readlane(__builtin_bit_cast(int, v), 16));
    const float s2 = __builtin_bit_cast(float, __builtin_amdgcn_readlane(__builtin_bit_cast(int, v), 32)), s3 = __builtin_bit_cast(float, __builtin_amdgcn_readlane(__builtin_bit_cast(int, v), 48));
    return (s0 + s1) + (s2 + s3);
}
#define LDS_WAIT() asm volatile("s_waitcnt lgkmcnt(0)" ::: "memory")

struct Args {
    const float* in[33]; float* out; unsigned char* ws; int ph_lo, ph_hi, dry, pad;
};

#define XB_TMO      128
#define XB_XCNT(j)  (256  + 64 * (j))
#define XB_XSUB(j)  (1280 + 64 * (j))
#define XB_XGEN(j)  (2304 + 64 * (j))
#define XB_TOP      3328
#define XB_TOPGEN   3392
#define XCD_BAR_WORDS 3456
#define XB_SPIN_CAP (1u << 18)

__device__ __forceinline__ unsigned xb_ld(unsigned* p)              { return __hip_atomic_load(p, __ATOMIC_RELAXED, __HIP_MEMORY_SCOPE_AGENT); }
__device__ __forceinline__ unsigned xb_add(unsigned* p, unsigned v) { return __hip_atomic_fetch_add(p, v, __ATOMIC_RELAXED, __HIP_MEMORY_SCOPE_AGENT); }
__device__ __forceinline__ unsigned xb_xcc_id() { return (unsigned)__builtin_amdgcn_s_getreg((3 << 11) | 20) & 0xFu; }
#define XB_SPIN(cond, bar) do { unsigned _sp = 0; while (cond) { __builtin_amdgcn_s_sleep(1); \
    if ((++_sp & 255u) == 0u) { if (xb_ld(&(bar)[XB_TMO])) break; if (_sp > XB_SPIN_CAP) { atomicAdd(&(bar)[XB_TMO], 1u); break; } } } } while (0)

struct XcdBarrier {
    unsigned* bar; unsigned x;
    volatile LAS unsigned* st;
};

__device__ __forceinline__ XcdBarrier xcd_barrier_post(unsigned* bar, volatile LAS unsigned* st) {
    XcdBarrier b; b.bar = bar; b.x = xb_xcc_id(); b.st = st;
    if (threadIdx.x == 0) (void)xb_add(&bar[XB_XCNT(b.x)], 1u);
    return b;
}
__device__ __forceinline__ void xcd_barrier_complete(unsigned* bar, unsigned x, unsigned& nloc, unsigned& nx) {
    const unsigned G = gridDim.x * gridDim.y * gridDim.z;
    unsigned sum, cnt, mine, sp = 0u;
    for (;;) {
        sum = 0u; cnt = 0u; mine = 0u;
#pragma unroll
        for (unsigned j = 0; j < 16; ++j) { const unsigned c = xb_ld(&bar[XB_XCNT(j)]); sum += c; cnt += (c > 0u) ? 1u : 0u; mine = (j == x) ? c : mine; }
        if (sum == G) break;
        __builtin_amdgcn_s_sleep(1);
        if ((++sp & 255u) == 0u) { if (xb_ld(&bar[XB_TMO])) break; if (sp > XB_SPIN_CAP) { atomicAdd(&bar[XB_TMO], 1u); break; } }
    }
    nloc = mine > 0u ? mine : 1u; nx = cnt > 0u ? cnt : 1u;
}

__device__ __forceinline__ void xcd_barrier(const XcdBarrier& b) {
    asm volatile("s_waitcnt vmcnt(0)" ::: "memory");
    __syncthreads();
    if (threadIdx.x == 0) {
        unsigned* bar = b.bar;
        __builtin_amdgcn_s_waitcnt(0);
        unsigned nloc = b.st[0], nx = b.st[1];
        if (nloc == 0u) { xcd_barrier_complete(bar, b.x, nloc, nx); b.st[0] = nloc; b.st[1] = nx; }
        const unsigned old = xb_add(&bar[XB_XSUB(b.x)], 1u);
        const unsigned gen = old / nloc;
        if (old + 1u == (gen + 1u) * nloc) {
            __builtin_amdgcn_fence(__ATOMIC_RELEASE, "agent");
            asm volatile("s_waitcnt vmcnt(0)" ::: "memory");
            const unsigned og = xb_add(&bar[XB_TOP], 1u);
            const unsigned tg = og / nx;
            if (og + 1u == (tg + 1u) * nx) xb_add(&bar[XB_TOPGEN], 1u);
            else XB_SPIN(xb_ld(&bar[XB_TOPGEN]) == tg, bar);
            __builtin_amdgcn_fence(__ATOMIC_ACQUIRE, "agent");
            xb_add(&bar[XB_XGEN(b.x)], 1u);
            asm volatile("s_waitcnt vmcnt(0)" ::: "memory");
        } else {
            XB_SPIN(xb_ld(&bar[XB_XGEN(b.x)]) == gen, bar);
            __builtin_amdgcn_fence(__ATOMIC_ACQUIRE, "agent");
            asm volatile("s_waitcnt vmcnt(0)" ::: "memory");
        }
    }
    __syncthreads();
}

namespace pg8 {
#define PG8_LAS __attribute__((address_space(3)))
typedef unsigned short bf16_t;
typedef short bf16x8 __attribute__((ext_vector_type(8)));
typedef float f32x4 __attribute__((ext_vector_type(4)));
typedef unsigned u32x4 __attribute__((ext_vector_type(4)));
constexpr int BM = 256, BK = 64, HALF = 128, HTB = HALF * BK * 2  , STAGE_BYTES = 8 * HTB, NXCD = 8, WGM = 8;

__host__ __device__ __forceinline__ int lds_byte(int r, int c) { const int st = (r >> 4) * 2 + (c >> 5), rr = r & 15, cc = c & 31, ob = rr * 64 + cc * 2; return st * 1024 + (ob ^ (((ob >> 9) & 1) << 5)); }
__host__ __device__ __forceinline__ void stage_rc(int b, int& R, int& C) { const int st = b / 1024, sb = b % 1024, swz = sb ^ (((sb >> 9) & 1) << 5); R = (st >> 1) * 16 + swz / 64; C = (st & 1) * 32 + (swz % 64) / 2; }
__host__ __device__ __forceinline__ int perm32(int rho) { const int n = rho >> 4, i = rho & 15; return 8 * (i >> 2) + 4 * n + (i & 3); }

struct Unit { int pm, pn, kt0, knt, slab; };
struct Gemm { const bf16_t* A; const bf16_t* Bt; int M, N, K; };

struct StaticOrder {
    static constexpr bool SPLIT = false;
    int nM, nN, nwg, G, c;
    __host__ __device__ __forceinline__ void init(int M, int N, int G_, int c_) { nM = M / BM; nN = N / BM; nwg = nM * nN; G = G_; c = c_; }
    __host__ __device__ __forceinline__ bool next(int i, Unit& u) const {
        const long L = (long)i * G + c; if (L >= nwg) return false;
        int wgid = (int)L; { const int q = nwg / NXCD, r = nwg % NXCD, xcd = wgid % NXCD, off = wgid / NXCD; wgid = (xcd < r ? xcd * (q + 1) : r * (q + 1) + (xcd - r) * q) + off; }
        const int nig = WGM * nN, gid = wgid / nig, fm = gid * WGM, gsz = (nM - fm) < WGM ? (nM - fm) : WGM;
        u.pm = fm + ((wgid % nig) % gsz); u.pn = (wgid % nig) / gsz; return true;
    }
    __device__ __forceinline__ void a_ready(const Unit&) const {}
    __device__ __forceinline__ void done(const Unit&) const {}
};

struct SplitOrder {
    static constexpr bool SPLIT = true;
    int nM, nN, nwg, G, c, ntk, full, S, npieces, nMf;
    __host__ __device__ __forceinline__ void init(int M, int N, int K, int G_, int c_, int S_) { nM = M / BM; nN = N / BM; nwg = nM * nN; G = G_; c = c_; ntk = K / BK; full = (nwg / G) * G;
        S = S_; if (full == nwg || S < 1 || (full % nN) != 0 || full == 0) { S = 1; full = nwg; } nMf = full / nN; npieces = (nwg - full) * S; }
    __host__ __device__ __forceinline__ bool next(int i, Unit& u) const {
        const long L = (long)i * G + c;
        if (L < full) {
            int wgid = (int)L; { const int q = full / NXCD, r = full % NXCD, xcd = wgid % NXCD, off = wgid / NXCD; wgid = (xcd < r ? xcd * (q + 1) : r * (q + 1) + (xcd - r) * q) + off; }
            const int nig = WGM * nN, gid = wgid / nig, fm = gid * WGM, gsz = (nMf - fm) < WGM ? (nMf - fm) : WGM;
            u.pm = fm + ((wgid % nig) % gsz); u.pn = (wgid % nig) / gsz; u.kt0 = 0; u.knt = ntk; u.slab = -1; return true; }
        const long P = L - full; if (P >= npieces) return false;
        const int tile = (int)(P / S), s = (int)(P % S); u.pm = nMf + tile / nN; u.pn = tile % nN; const int kb = (ntk / S) & ~1;
        u.kt0 = s * kb; u.knt = s == S - 1 ? ntk - kb * (S - 1) : kb; u.slab = (int)P; return true;
    }
    __device__ __forceinline__ void a_ready(const Unit&) const {}
    __device__ __forceinline__ void done(const Unit&) const {}
};

__device__ __forceinline__ unsigned cvt_pk_bf16(float lo, float hi) { return pk2(lo, hi); }
typedef unsigned u32x2 __attribute__((ext_vector_type(2)));
template <class Epi, class Sched, bool ALIGN_EPI = false, bool SP2 = false>
__device__ __forceinline__ void gemm_phase(PG8_LAS unsigned char* lds, const Gemm g, const Sched& S, const Epi& E) {
    const int tid = threadIdx.x, wid = __builtin_amdgcn_readfirstlane(tid >> 6), lane = tid & 63, wr = wid >> 2, wc = wid & 3, fr = lane & 15, fq = lane >> 4;
    const int K = g.K; int nt = K / BK;
    unsigned voffA[2], voffB[2];
#pragma unroll
    for (int i = 0; i < 2; ++i) { int R, C; stage_rc(tid * 16 + i * 8192, R, C); const int Rb = Epi::PERM ? ((R & ~31) + perm32(R & 31)) : R;
        voffA[i] = (unsigned)(R * K + C) * 2u; voffB[i] = (unsigned)(Rb * K + C) * 2u; }
    const size_t kstep = (size_t)(BK * 2);
    const size_t hstep = (size_t)HALF * K * 2;
    const size_t tstep = 2 * hstep;
    const unsigned ldsw = (unsigned)wid * 1024u;
    const int aoff = lds_byte(wr * 64 + fr, fq * 8), boff = lds_byte(wc * 32 + fr, fq * 8);
#define PG8_SA(b, h) (((b) * 2 + (h)) * HTB)
#define PG8_SB(b, h) ((4 + (b) * 2 + (h)) * HTB)
#define PG8_STAGE(bufoff, gbase, voff) do { _Pragma("unroll") for (int _i = 0; _i < 2; ++_i) \
        __builtin_amdgcn_global_load_lds((const unsigned*)((const char*)(gbase) + (voff)[_i]), (PG8_LAS unsigned*)(lds + (bufoff) + ldsw + _i * 8192), 16, 0, 0); } while (0)
#define PG8_LDA(dst, b, h) do { _Pragma("unroll") for (int m = 0; m < 4; ++m) _Pragma("unroll") for (int k = 0; k < 2; ++k) dst[m][k] = *(const PG8_LAS bf16x8*)(lds + PG8_SA(b, h) + aoff + m * 2048 + k * 1024); } while (0)
#define PG8_LDB(dst, b, h) do { _Pragma("unroll") for (int n = 0; n < 2; ++n) _Pragma("unroll") for (int k = 0; k < 2; ++k) dst[n][k] = *(const PG8_LAS bf16x8*)(lds + PG8_SB(b, h) + boff + n * 2048 + k * 1024); } while (0)
#define PG8_MMA(ai, bj, At, Bt) do { __builtin_amdgcn_s_setprio(1); _Pragma("unroll") for (int m = 0; m < 4; ++m) _Pragma("unroll") for (int n = 0; n < 2; ++n) _Pragma("unroll") for (int k = 0; k < 2; ++k) \
        acc[ai][bj][m][n] = __builtin_amdgcn_mfma_f32_16x16x32_bf16(Bt[n][k], At[m][k], acc[ai][bj][m][n], 0, 0, 0); __builtin_amdgcn_s_setprio(0); } while (0)
#define PG8_WAIT_V(n) asm volatile("s_waitcnt vmcnt(" #n ")" ::: "memory")
#define PG8_WAIT_L(n) asm volatile("s_waitcnt lgkmcnt(" #n ")" ::: "memory")
#define PG8_BAR __builtin_amdgcn_s_barrier()
#define PG8_SCHED __builtin_amdgcn_sched_barrier(0)
    Unit cur, nxt; int ui = 0;
    if (!S.next(0, cur)) return;
    f32x4 acc[2][2][4][2];
#pragma unroll
    for (int a = 0; a < 2; ++a)
#pragma unroll
        for (int b = 0; b < 2; ++b)
#pragma unroll
            for (int m = 0; m < 4; ++m)
#pragma unroll
                for (int n = 0; n < 2; ++n) acc[a][b][m][n] = (f32x4){0.f, 0.f, 0.f, 0.f};
    bf16x8 At[4][2], B0[2][2], B1[2][2];
    const char* cA = (const char*)g.A + (size_t)cur.pm * tstep; const char* cB = (const char*)g.Bt + (size_t)cur.pn * tstep;
    if constexpr (Sched::SPLIT) { nt = cur.knt; cA += (size_t)cur.kt0 * kstep; cB += (size_t)cur.kt0 * kstep; }
    S.a_ready(cur);
    if constexpr (SP2) {
        PG8_STAGE(PG8_SB(0, 0), cB, voffB); PG8_STAGE(PG8_SB(0, 1), cB + hstep, voffB); PG8_STAGE(PG8_SA(0, 0), cA, voffA); PG8_STAGE(PG8_SA(0, 1), cA + hstep, voffA);
        if (wr == 1) PG8_BAR;
        PG8_WAIT_V(2); PG8_BAR;
        PG8_STAGE(PG8_SB(1, 0), cB + kstep, voffB); PG8_STAGE(PG8_SA(1, 0), cA + kstep, voffA); PG8_STAGE(PG8_SB(1, 1), cB + hstep + kstep, voffB);
        PG8_WAIT_V(6); PG8_BAR;
    } else {
        PG8_STAGE(PG8_SB(0, 0), cB, voffB); PG8_STAGE(PG8_SA(0, 0), cA, voffA); PG8_STAGE(PG8_SB(0, 1), cB + hstep, voffB); PG8_STAGE(PG8_SA(0, 1), cA + hstep, voffA);
        if (wr == 1) PG8_BAR;
        PG8_WAIT_V(4); PG8_BAR;
        PG8_STAGE(PG8_SB(1, 0), cB + kstep, voffB); PG8_STAGE(PG8_SA(1, 0), cA + kstep, voffA); PG8_STAGE(PG8_SB(1, 1), cB + hstep + kstep, voffB);
        PG8_WAIT_V(6); PG8_BAR;
    }
    for (;;) {
        const bool has_next = S.next(ui + 1, nxt);
        const char* nA = has_next ? (const char*)g.A + (size_t)nxt.pm * tstep : cA; const char* nB = has_next ? (const char*)g.Bt + (size_t)nxt.pn * tstep : cB;
        if constexpr (Sched::SPLIT) { if (has_next) { nA += (size_t)nxt.kt0 * kstep; nB += (size_t)nxt.kt0 * kstep; } }
        for (int t = 0; t < nt; t += 2) {
            const bool last = (t == nt - 2);
            const char* a1 = cA + (size_t)(t + 1) * kstep;
            const char* a2 = last ? nA : cA + (size_t)(t + 2) * kstep; const char* b2 = last ? nB : cB + (size_t)(t + 2) * kstep;
            const char* a3 = a2 + kstep; const char* b3 = b2 + kstep;
            if (last && has_next) S.a_ready(nxt);
            if constexpr (SP2) {
            PG8_LDB(B0, 0, 0); PG8_LDB(B1, 0, 1); PG8_SCHED; PG8_LDA(At, 0, 0); PG8_STAGE(PG8_SA(1, 1), a1 + hstep, voffA);
            PG8_WAIT_V(8); PG8_WAIT_L(0); PG8_BAR; PG8_MMA(0, 0, At, B0); PG8_MMA(0, 1, At, B1); PG8_BAR; PG8_SCHED;
            PG8_LDA(At, 0, 1); PG8_STAGE(PG8_SB(0, 0), b2, voffB); PG8_STAGE(PG8_SB(0, 1), b2 + hstep, voffB); PG8_STAGE(PG8_SA(0, 0), a2, voffA);
            PG8_WAIT_V(8); PG8_WAIT_L(0); PG8_BAR; PG8_MMA(1, 0, At, B0); PG8_MMA(1, 1, At, B1); PG8_BAR; PG8_SCHED;
            PG8_LDB(B0, 1, 0); PG8_LDB(B1, 1, 1); PG8_SCHED; PG8_LDA(At, 1, 0); PG8_STAGE(PG8_SA(0, 1), a2 + hstep, voffA);
            PG8_WAIT_V(8); PG8_WAIT_L(0); PG8_BAR; PG8_MMA(0, 0, At, B0); PG8_MMA(0, 1, At, B1); PG8_BAR; PG8_SCHED;
            PG8_LDA(At, 1, 1); PG8_STAGE(PG8_SB(1, 0), b3, voffB); PG8_STAGE(PG8_SB(1, 1), b3 + hstep, voffB); PG8_STAGE(PG8_SA(1, 0), a3, voffA);
            PG8_WAIT_V(8); PG8_WAIT_L(0); PG8_BAR; PG8_MMA(1, 0, At, B0); PG8_MMA(1, 1, At, B1); PG8_BAR; PG8_SCHED;
            } else {
            PG8_LDB(B0, 0, 0); PG8_SCHED; PG8_LDA(At, 0, 0); PG8_STAGE(PG8_SA(1, 1), a1 + hstep, voffA);
            PG8_WAIT_L(8); PG8_BAR; PG8_WAIT_L(0); PG8_MMA(0, 0, At, B0); PG8_BAR; PG8_SCHED;
            PG8_LDB(B1, 0, 1); PG8_STAGE(PG8_SB(0, 0), b2, voffB);
            PG8_BAR; PG8_WAIT_L(0); PG8_MMA(0, 1, At, B1); PG8_BAR;
            PG8_LDA(At, 0, 1); PG8_STAGE(PG8_SA(0, 0), a2, voffA);
            PG8_BAR; PG8_WAIT_L(0); PG8_MMA(1, 0, At, B0); PG8_BAR; PG8_SCHED;
            PG8_STAGE(PG8_SB(0, 1), b2 + hstep, voffB);
            PG8_WAIT_V(6); PG8_BAR; PG8_MMA(1, 1, At, B1); PG8_BAR;
            PG8_LDB(B0, 1, 0); PG8_SCHED; PG8_LDA(At, 1, 0); PG8_STAGE(PG8_SA(0, 1), a2 + hstep, voffA);
            PG8_WAIT_L(8); PG8_BAR; PG8_WAIT_L(0); PG8_MMA(0, 0, At, B0); PG8_BAR; PG8_SCHED;
            PG8_LDB(B1, 1, 1); PG8_STAGE(PG8_SB(1, 0), b3, voffB);
            PG8_BAR; PG8_WAIT_L(0); PG8_MMA(0, 1, At, B1); PG8_BAR;
            PG8_LDA(At, 1, 1); PG8_STAGE(PG8_SA(1, 0), a3, voffA);
            PG8_BAR; PG8_WAIT_L(0); PG8_MMA(1, 0, At, B0); PG8_BAR; PG8_SCHED;
            PG8_STAGE(PG8_SB(1, 1), b3 + hstep, voffB);
            PG8_WAIT_V(6); PG8_BAR; PG8_MMA(1, 1, At, B1); PG8_BAR;
            }
        }
        if constexpr (ALIGN_EPI) { if (wr == 0) PG8_BAR; }
        if constexpr (!Epi::AFTER_DRAIN) { E(acc, cur, wr, wc, fr, fq); S.done(cur); }
        if (!has_next) break;
#pragma unroll
        for (int a = 0; a < 2; ++a)
#pragma unroll
            for (int b = 0; b < 2; ++b)
#pragma unroll
                for (int m = 0; m < 4; ++m)
#pragma unroll
                    for (int n = 0; n < 2; ++n) acc[a][b][m][n] = (f32x4){0.f, 0.f, 0.f, 0.f};
        cur = nxt; cA = nA; cB = nB; ++ui;
        if constexpr (Sched::SPLIT) nt = cur.knt;
        if constexpr (ALIGN_EPI) { if (wr == 1) PG8_BAR; }
    }
    PG8_WAIT_V(0);
    if constexpr (!ALIGN_EPI) { if (wr == 0) PG8_BAR; }
    PG8_BAR;
    if constexpr (Epi::AFTER_DRAIN) { E.fused(acc, cur, wr, wc, fr, fq, lds, wid, lane); S.done(cur); }
#undef PG8_SA
#undef PG8_SB
#undef PG8_STAGE
#undef PG8_LDA
#undef PG8_LDB
#undef PG8_MMA
#undef PG8_WAIT_V
#undef PG8_WAIT_L
#undef PG8_BAR
#undef PG8_SCHED
}
}

namespace pg8 {
struct EpiInProj {
    static constexpr bool PERM = true, AFTER_DRAIN = false;
    unsigned char* ra;
    __device__ __forceinline__ void operator()(const f32x4 (&acc)[2][2][4][2], const Unit& u, int wr, int wc, int fr, int fq) const {
        const int pn = u.pn; bf16_t* base; int ld, coff;
        if (pn < 4) { base = (bf16_t*)(ra + RA_PZ); ld = 1024; coff = 256 * pn; }
        else if (pn < 10) { base = (bf16_t*)(ra + RA_PXBC); ld = 1536; coff = 256 * (pn - 4); }
        else if (pn < 14) { base = (bf16_t*)(ra + RA_PX0); ld = 1024; coff = 256 * (pn - 10); }
        else if (pn < 18) { base = (bf16_t*)(ra + RA_PX1); ld = 1024; coff = 256 * (pn - 14); }
        else if (pn < 22) { base = (bf16_t*)(ra + RA_PV); ld = 1024; coff = 256 * (pn - 18); }
        else { base = (bf16_t*)(ra + RA_PDT); ld = 32; coff = 0; }
        const bool dt_tile = (pn >= 22); const bool gm = (pn >= 10 && pn < 22);
        if (dt_tile && wc != 0) return;
        const int row0 = u.pm * BM + wr * 64 + fr;
#pragma unroll
        for (int ai = 0; ai < 2; ++ai)
#pragma unroll
            for (int m = 0; m < 4; ++m) {
                const int row = row0 + ai * HALF + m * 16;
#pragma unroll
                for (int bj = 0; bj < 2; ++bj) {
                    if (dt_tile && bj != 0) continue;
                    const int col = coff + bj * HALF + wc * 32 + 8 * fq;
                    bf16_t* dst = gm ? base + ((size_t)(col >> 3) * MALL + row) * 8 : base + (size_t)row * ld + col;
                    const f32x4 v0 = acc[ai][bj][m][0], v1 = acc[ai][bj][m][1];
                    u32x4 w; w.x = cvt_pk_bf16(v0[0], v0[1]); w.y = cvt_pk_bf16(v0[2], v0[3]); w.z = cvt_pk_bf16(v1[0], v1[1]); w.w = cvt_pk_bf16(v1[2], v1[3]);
                    __builtin_nontemporal_store(w, (u32x4*)dst);
                }
            }
    }
};
struct EpiQKV {
    static constexpr bool PERM = false, AFTER_DRAIN = false;
    unsigned char* ra; const float* rope; float qscale;
    __device__ __forceinline__ void operator()(const f32x4 (&acc)[2][2][4][2], const Unit& u, int wr, int wc, int fr, int fq) const {
        const int pn = u.pn; const int row0 = u.pm * BM + wr * 64 + fr;
        {
            bf16_t* base = pn < 4 ? (bf16_t*)(ra + RA_Q) + 256 * pn : (pn == 4 ? (bf16_t*)(ra + RA_K) : (bf16_t*)(ra + RA_V)); const int ld = pn < 4 ? 1024 : 256; const float sc = pn < 4 ? qscale : 1.0f;
            const bool isv = pn >= 5;
#pragma unroll
            for (int ai = 0; ai < 2; ++ai)
#pragma unroll
                for (int m = 0; m < 4; ++m) {
                    const int row = row0 + ai * HALF + m * 16; const bool lat = row < MLAT && !isv; const int t = row & (SEQ - 1);
                    const int pos = (wc & 1) ? (t & 63) : (t >> 6);
                    f32x4 cs0 = (f32x4){1.f, 0.f, 1.f, 0.f}, cs1 = cs0;
                    if (lat) { const f32x4* rp = (const f32x4*)(rope + (size_t)(pos * 16 + 4 * fq) * 2); cs0 = rp[0]; cs1 = rp[1]; }
                    bf16_t* rowp = base + (size_t)row * ld + wc * 32 + 4 * fq;
#pragma unroll
                    for (int bj = 0; bj < 2; ++bj) {
                        const f32x4 x1 = acc[ai][bj][m][0], x2 = acc[ai][bj][m][1];
                        f32x4 o1, o2;
                        o1[0] = x1[0] * cs0[0] - x2[0] * cs0[1]; o2[0] = x2[0] * cs0[0] + x1[0] * cs0[1];
                        o1[1] = x1[1] * cs0[2] - x2[1] * cs0[3]; o2[1] = x2[1] * cs0[2] + x1[1] * cs0[3];
                        o1[2] = x1[2] * cs1[0] - x2[2] * cs1[1]; o2[2] = x2[2] * cs1[0] + x1[2] * cs1[1];
                        o1[3] = x1[3] * cs1[2] - x2[3] * cs1[3]; o2[3] = x2[3] * cs1[2] + x1[3] * cs1[3];
                        o1 = o1 * sc; o2 = o2 * sc;
                        u32x2 w0, w1; w0.x = cvt_pk_bf16(o1[0], o1[1]); w0.y = cvt_pk_bf16(o1[2], o1[3]); w1.x = cvt_pk_bf16(o2[0], o2[1]); w1.y = cvt_pk_bf16(o2[2], o2[3]);
                        *(u32x2*)(rowp + bj * HALF) = w0; *(u32x2*)(rowp + bj * HALF + 16) = w1;
                    }
                }
        }
    }
};
template <bool FIRST> struct EpiResidT {
    static constexpr bool PERM = true, AFTER_DRAIN = false;
    float* xl; float* xc; const float* gate; float* slabs; const float* xl_rd; const float* xc_rd;
    __device__ __forceinline__ void operator()(const f32x4 (&acc)[2][2][4][2], const Unit& u, int wr, int wc, int fr, int fq) const {
        const int row0 = u.pm * BM + wr * 64 + fr; const int col0 = u.pn * BM + wc * 32 + 8 * fq;
        bf16_t* sl = (bf16_t*)slabs + (size_t)(u.slab < 0 ? 0 : u.slab) * (BM * BM) + (size_t)(wr * 64 + fr) * BM + wc * 32 + 8 * fq;
#pragma unroll
        for (int ai = 0; ai < 2; ++ai)
#pragma unroll
            for (int m = 0; m < 4; ++m) {
                const int row = row0 + ai * HALF + m * 16; const bool lat = row < MLAT;
                float* xrow = lat ? xl + (size_t)row * DM : xc + (size_t)(row - MLAT) * DM; const float* xrd = FIRST ? (lat ? xl_rd + (size_t)row * DM : xc_rd + (size_t)(row - MLAT) * DM) : (const float*)xrow; const float* grow = gate + (size_t)(lat ? (row >> 11) : 8) * MODW;
#pragma unroll
                for (int bj = 0; bj < 2; ++bj)
#pragma unroll
                    for (int n = 0; n < 2; ++n) { const int c = col0 + bj * HALF + n * 4;
                        const f32x4 gv = *(const f32x4*)(grow + c); const f32x4 dv = gv * acc[ai][bj][m][n];
                        if (u.slab < 0) { f32x4 xv = *(const f32x4*)(xrd + c); xv = xv + dv; *(f32x4*)(xrow + c) = xv; }
                        else { u32x2 w; w.x = cvt_pk_bf16(dv[0], dv[1]); w.y = cvt_pk_bf16(dv[2], dv[3]); *(u32x2*)(sl + (size_t)(ai * HALF + m * 16) * BM + bj * HALF + n * 4) = w; } }
            }
    }
};
struct EpiSwiGLU {
    static constexpr bool PERM = true, AFTER_DRAIN = false;
    bf16_t* act;
    __device__ __forceinline__ void operator()(const f32x4 (&acc)[2][2][4][2], const Unit& u, int wr, int wc, int fr, int fq) const {
        const int row0 = u.pm * BM + wr * 64 + fr; const int col0 = u.pn * HALF + wc * 32 + 8 * fq;
#pragma unroll
        for (int ai = 0; ai < 2; ++ai)
#pragma unroll
            for (int m = 0; m < 4; ++m) {
                float o[8];
#pragma unroll
                for (int n = 0; n < 2; ++n)
#pragma unroll
                    for (int e = 0; e < 4; ++e) { const float g = acc[ai][0][m][n][e], uu = acc[ai][1][m][n][e]; o[4 * n + e] = g * __builtin_amdgcn_rcpf(1.f + __expf(-g)) * uu; }
                u32x4 w; w.x = cvt_pk_bf16(o[0], o[1]); w.y = cvt_pk_bf16(o[2], o[3]); w.z = cvt_pk_bf16(o[4], o[5]); w.w = cvt_pk_bf16(o[6], o[7]);
                __builtin_nontemporal_store(w, (u32x4*)(act + (size_t)(row0 + ai * HALF + m * 16) * FFH + col0));
            }
    }
};
}

struct Frame {
    LAS unsigned char* lds;
    int tid, lane, wave, G, bid;
    float* out; unsigned char* ws;
};
enum { I_X = 0, I_C, I_CTX, I_CCTX, I_ADAW, I_ADAB, I_N1G, I_N2G, I_HYINW, I_SCONVW, I_SCONVB, I_SDTB, I_SALOG, I_SD, I_SNORMG, I_HCONVW, I_HCONVB,
       I_HW1, I_HB1, I_HW2, I_HB2, I_HW3, I_HB3, I_HW4, I_HFREQ, I_HBIAS, I_HYOUTW, I_QKVW, I_SINKS, I_AOUTW, I_FFNIN, I_FFNOUT, I_FINALG };

__device__ __forceinline__ int src_col32(int kind, int n0) {
    if (kind == 0) return n0;
    if (kind == 1) { if (n0 < 2560) return n0; if (n0 < 5632) return n0 + 32; if (n0 < 5664) return n0 - 5632 + 2560; return -1; }
    const int pn = n0 >> 8, w = n0 & 255; return w < 128 ? 128 * pn + w : FFH + 128 * pn + (w - 128);
}
__device__ __forceinline__ void transpose_item(const float* W, int K, int Nsrc, bf16* WT, int kind, int nblk, LAS float* scr, int item, int lane) {
    const int kb = item / nblk, nb = item % nblk, k0 = 64 * kb, n0 = 32 * nb; const int sc0 = src_col32(kind, n0);
    float tv[32];
#pragma unroll
    for (int i = 0; i < 32; ++i) { const int kk = 2 * i + (lane >> 5); tv[i] = sc0 >= 0 ? W[(size_t)(k0 + kk) * Nsrc + sc0 + (lane & 31)] : 0.f; }
#pragma unroll
    for (int i = 0; i < 32; ++i) { const int kk = 2 * i + (lane >> 5); scr[kk * 33 + (lane & 31)] = tv[i]; }
    LDS_WAIT();
    const int c = lane & 7;
#pragma unroll
    for (int j = 0; j < 4; ++j) { const int n = (lane >> 3) + 8 * j; const LAS float* s = scr + (8 * c) * 33 + n;
        v4u o; o.x = pk2(s[0 * 33], s[1 * 33]); o.y = pk2(s[2 * 33], s[3 * 33]); o.z = pk2(s[4 * 33], s[5 * 33]); o.w = pk2(s[6 * 33], s[7 * 33]);
        *(v4u*)(WT + (size_t)(n0 + n) * K + k0 + 8 * c) = o; }
    LDS_WAIT();
}
__device__ __forceinline__ void convert_weights(Frame& F, const Args& A, int layer, int which, int b0) {
    LAS float* scr = (LAS float*)(F.lds + F.wave * 16384);
    if (F.bid < b0) return;
    const int gw = (F.bid - b0) * NWAVES + F.wave, NGW = (F.G - b0) * NWAVES; const int j = layer >> 1;
    bf16* WA = (bf16*)(F.ws + WS_WA); bf16* WB = (bf16*)(F.ws + WS_WB); bf16* WC = (bf16*)(F.ws + WS_WC); bf16* WD = (bf16*)(F.ws + WS_WD);
    const float* ffin = A.in[I_FFNIN] + (size_t)layer * DM * 2 * FFH; const float* ffout = A.in[I_FFNOUT] + (size_t)layer * FFH * DM;
    int I_A, I_B; const int I_C_ = (DM / 64) * (2 * FFH / 32), I_D_ = (FFH / 64) * (DM / 32);
    if ((layer & 1) == 0) { I_A = (DM / 64) * (INP / 32); I_B = (2048 / 64) * (DM / 32); } else { I_A = (DM / 64) * (QKV_COLS / 32); I_B = (DM / 64) * (DM / 32); }
    const int NIT = I_A + I_B + I_C_ + I_D_;
    const int it_lo = (which & 1) ? 0 : I_A + I_B, it_hi = (which & 2) ? NIT : I_A + I_B;
    for (int it = it_lo + gw; it < it_hi; it += NGW) {
        int r = it;
        if (r < I_A) { if ((layer & 1) == 0) transpose_item(A.in[I_HYINW] + (size_t)j * DM * IN_COLS, DM, IN_COLS, WA, 1, INP / 32, scr, r, F.lane);
                       else transpose_item(A.in[I_QKVW] + (size_t)j * DM * QKV_COLS, DM, QKV_COLS, WA, 0, QKV_COLS / 32, scr, r, F.lane); continue; } r -= I_A;
        if (r < I_B) { if ((layer & 1) == 0) transpose_item(A.in[I_HYOUTW] + (size_t)j * 2048 * DM, 2048, DM, WB, 0, DM / 32, scr, r, F.lane);
                       else transpose_item(A.in[I_AOUTW] + (size_t)j * DM * DM, DM, DM, WB, 0, DM / 32, scr, r, F.lane); continue; } r -= I_B;
        if (r < I_C_) { transpose_item(ffin, DM, 2 * FFH, WC, 2, 2 * FFH / 32, scr, r, F.lane); continue; } r -= I_C_;
        transpose_item(ffout, FFH, DM, WD, 0, DM / 32, scr, r, F.lane);
    }
}

__device__ __forceinline__ void copy_inputs(Frame& F, const Args& A) {
    const size_t gt = (size_t)F.bid * NTHREADS + F.tid, GT = (size_t)F.G * NTHREADS;
    if (F.G != 256) { const f32x4* cs = (const f32x4*)A.in[I_CTX]; f32x4* cd = (f32x4*)(F.ws + WS_XC); for (size_t i = gt; i < (size_t)MCTX * DM / 4; i += GT) cd[i] = cs[i]; }
    float* rope = (float*)(F.ws + WS_ROPE);
    for (size_t i = gt; i < 64 * 16; i += GT) { const int pos = (int)(i >> 4), f = (int)(i & 15); const float inv = powf(10000.0f, -(float)f / 16.0f); const float ang = (float)pos * inv;
        rope[2 * i] = cosf(ang); rope[2 * i + 1] = sinf(ang); }
}
__device__ __forceinline__ void mod_unit(Frame& F, const Args& A, int unit) {
    LAS float* sL = (LAS float*)F.lds;
    LAS float* red = (LAS float*)(F.lds + 9 * 1024 * 4);
    const int l = unit / 96, cc = unit % 96;
    for (int i = F.tid; i < 9 * 1024; i += NTHREADS) { const int r = i >> 10, k = i & 1023; const float v = r < 8 ? A.in[I_C][r * DM + k] : A.in[I_CCTX][k]; sL[i] = siluf(v); }
    __syncthreads();
    const int col = cc * 64 + (F.tid & 63), kq = F.tid >> 6;
    const float* w = A.in[I_ADAW] + (size_t)l * DM * MODW + col;
    float acc[9];
#pragma unroll
    for (int r = 0; r < 9; ++r) acc[r] = 0.f;
    for (int k0 = kq * 128; k0 < kq * 128 + 128; k0 += 16) {
        float wv[16];
#pragma unroll
        for (int i = 0; i < 16; ++i) wv[i] = w[(size_t)(k0 + i) * MODW];
#pragma unroll
        for (int i = 0; i < 16; ++i) {
#pragma unroll
            for (int r = 0; r < 9; ++r) acc[r] += sL[r * 1024 + k0 + i] * wv[i]; } }
#pragma unroll
    for (int r = 0; r < 9; ++r) red[(kq * 9 + r) * 64 + (F.tid & 63)] = acc[r];
    __syncthreads();
    float* mod = (float*)(F.ws + WS_MOD);
    for (int i = F.tid; i < 9 * 64; i += NTHREADS) { const int r = i >> 6, c = i & 63; float s = 0.f;
#pragma unroll
        for (int q = 0; q < 8; ++q) s += red[(q * 9 + r) * 64 + c];
        mod[((size_t)l * 9 + r) * MODW + cc * 64 + c] = s + A.in[I_ADAB][(size_t)l * MODW + cc * 64 + c]; }
    __syncthreads();
}
constexpr int FT = 8;
__device__ __forceinline__ void filter_unit(Frame& F, const Args& A, int unit) {
    int j, Lsel, tile; { int u = unit; j = u / 288; u %= 288; if (u < 256) { Lsel = 0; tile = u; } else { Lsel = 1; tile = u - 256; } }
    const int L = Lsel == 0 ? SEQ : CTXL; const int t0 = tile * FT;
    LAS float* zL = (LAS float*)F.lds;
    LAS float* hA = zL + FT * 36;
    LAS float* hB = hA + FT * 64;
    const float* w1 = A.in[I_HW1] + (size_t)j * 33 * 64; const float* b1 = A.in[I_HB1] + j * 64;
    const float* w2 = A.in[I_HW2] + (size_t)j * 64 * 64; const float* b2 = A.in[I_HB2] + j * 64;
    const float* w3 = A.in[I_HW3] + (size_t)j * 64 * 64; const float* b3 = A.in[I_HB3] + j * 64;
    const float* w4 = A.in[I_HW4] + (size_t)j * 64 * 2048; const float* fr = A.in[I_HFREQ] + j * 3 * 64;
    for (int i = F.tid; i < FT * 33; i += NTHREADS) { const int tt = i / 33, q = i % 33; const float t = (float)(t0 + tt);
        float v;
        if (q == 0) v = t / (float)(L - 1);
        else { const int bi = (q - 1) & 15; const float fb = 1e-4f + (float)bi * ((15.0f - 1e-4f) / 15.0f); const float ang = (6.2831855f * t) / (float)L; const float a = ang * fb; v = q <= 16 ? cosf(a) : -sinf(a); }
        zL[tt * 36 + q] = v; }
    __syncthreads();
    for (int i = F.tid; i < FT * 64; i += NTHREADS) { const int tt = i >> 6, o = i & 63; float s = b1[o];
        for (int q = 0; q < 33; ++q) s += zL[tt * 36 + q] * w1[q * 64 + o];
        hA[tt * 64 + o] = sinf(fr[o] * s); }
    __syncthreads();
    for (int i = F.tid; i < FT * 64; i += NTHREADS) { const int tt = i >> 6, o = i & 63; float s = b2[o];
        for (int q = 0; q < 64; ++q) s += hA[tt * 64 + q] * w2[q * 64 + o];
        hB[tt * 64 + o] = sinf(fr[64 + o] * s); }
    __syncthreads();
    for (int i = F.tid; i < FT * 64; i += NTHREADS) { const int tt = i >> 6, o = i & 63; float s = b3[o];
        for (int q = 0; q < 64; ++q) s += hB[tt * 64 + q] * w3[q * 64 + o];
        hA[tt * 64 + o] = sinf(fr[128 + o] * s); }
    __syncthreads();
    bf16* Fb = (bf16*)(F.ws + WS_F + (size_t)j * F_LAYER + (Lsel ? 8 * MiB : 0));
    float* SS = (float*)(F.ws + WS_CTL) + (j * 2 + Lsel) * 1024;
    const float dmin = 3.0701134573253943f, dmax = 15.350567286626972f;
    for (int q = 0; q < 4; ++q) {
        const int cp = F.tid + 512 * q; const int c = cp & 1023; const bool bwd = cp >= 1024;
        float wr[64];
#pragma unroll
        for (int i = 0; i < 64; ++i) wr[i] = w4[(size_t)i * 2048 + cp];
        const float adelta = dmin + (float)c * ((dmax - dmin) / 1023.0f);
        float ssq = 0.f;
        for (int tt = 0; tt < FT; ++tt) {
            float s = 0.f;
#pragma unroll
            for (int i4 = 0; i4 < 16; ++i4) { const f32x4 h = *(const LAS f32x4*)(hA + tt * 64 + 4 * i4); s += h[0] * wr[4 * i4] + h[1] * wr[4 * i4 + 1] + h[2] * wr[4 * i4 + 2] + h[3] * wr[4 * i4 + 3]; }
            const int t = t0 + tt; const float tu = (float)t / (float)(L - 1);
            const float val = s * __expf(-tu * adelta);
            if (!bwd) { ssq += val * val; Fb[(size_t)c * 2 * L + (L + t)] = (bf16)f2bf(val); }
            else if (t > 0) { ssq += val * val; Fb[(size_t)c * 2 * L + (L - t)] = (bf16)f2bf(val); }
        }
        atomicAdd(SS + c, ssq);
        if (tile == 0 && !bwd) Fb[(size_t)c * 2 * L] = 0;
    }
    __syncthreads();
}

__device__ __forceinline__ void nm_phase(Frame& F, const Args& A, int layer, int ks, const float* g, int M, const float* slabs, int S, const float* xl_rd, const float* xc_rd) {
    const int gw = F.bid * NWAVES + F.wave, NGW = F.G * NWAVES;
    const float* mod = (const float*)(F.ws + WS_MOD) + (size_t)layer * 9 * MODW; bf16* HN = (bf16*)(F.ws + WS_RB);
    constexpr int NR = 4;
    for (int row0 = gw; row0 < M; row0 += NR * NGW) {
        f32x4 v[NR][4];
#pragma unroll
        for (int u = 0; u < NR; ++u) { const int row = row0 + u * NGW; const int rr = row < M ? row : row0; const bool lat = rr < MLAT;
            const float* xr = lat ? xl_rd + (size_t)rr * DM : xc_rd + (size_t)(rr - MLAT) * DM;
#pragma unroll
            for (int q = 0; q < 4; ++q) v[u][q] = *(const f32x4*)(xr + 4 * F.lane + 256 * q); }
#pragma unroll
        for (int u = 0; u < NR; ++u) { const int row = row0 + u * NGW; if (row >= M) break; const bool lat = row < MLAT;
            if (slabs != nullptr && !lat) {
                const int rl = row - MLAT; const bf16* sp = (const bf16*)slabs + (size_t)((rl >> 8) * 4) * S * 65536 + (size_t)(rl & 255) * 256 + 4 * F.lane;
                for (int s = 0; s < S; ++s) {
#pragma unroll
                    for (int q = 0; q < 4; ++q) { const v2u w = *(const v2u*)(sp + ((size_t)q * S + s) * 65536); v[u][q][0] += bflo(w.x); v[u][q][1] += bfhi(w.x); v[u][q][2] += bflo(w.y); v[u][q][3] += bfhi(w.y); } }
                float* xw = (float*)(F.ws + WS_XC) + (size_t)rl * DM;
#pragma unroll
                for (int q = 0; q < 4; ++q) *(f32x4*)(xw + 4 * F.lane + 256 * q) = v[u][q]; }
            const float* mr = mod + (size_t)(lat ? (row >> 11) : 8) * MODW; float ss = 0.f;
#pragma unroll
            for (int q = 0; q < 4; ++q) ss += (v[u][q][0] * v[u][q][0] + v[u][q][1] * v[u][q][1]) + (v[u][q][2] * v[u][q][2] + v[u][q][3] * v[u][q][3]);
            const float rstd = rsqrtf(wave_sum(ss) * (1.0f / DM) + NORM_EPS);
#pragma unroll
            for (int q = 0; q < 4; ++q) { const int c = 4 * F.lane + 256 * q;
                const f32x4 gg = *(const f32x4*)(g + c), sh = *(const f32x4*)(mr + ks * DM + c), sc = *(const f32x4*)(mr + (ks + 1) * DM + c);
                const f32x4 o = v[u][q] * rstd * gg * (sc + 1.0f) + sh;
                v2u w; w.x = pk2(o[0], o[1]); w.y = pk2(o[2], o[3]); *(v2u*)(HN + (size_t)row * DM + c) = w; } }
    }
}
__device__ __forceinline__ void gate_phase(Frame& F, const Args& A, int j) {
    const int gw = F.bid * NWAVES + F.wave, NGW = F.G * NWAVES;
    const bf16* YF = (const bf16*)(F.ws + WS_RA + RA_PX1); const bf16* YB = (const bf16*)(F.ws + WS_RA + RA_PV); const bf16* PZ = (const bf16*)(F.ws + WS_RA + RA_PZ);
    bf16* CAT = (bf16*)(F.ws + WS_RB); const float* ng = A.in[I_SNORMG] + j * 1024;
    constexpr int NR = 3;
    for (int row0 = gw; row0 < MALL; row0 += NR * NGW) {
        v4u ra[NR][2], rb[NR][2], rz[NR][2];
#pragma unroll
        for (int u = 0; u < NR; ++u) { const int row = row0 + u * NGW; const int rr = row < MALL ? row : row0;
#pragma unroll
            for (int q = 0; q < 2; ++q) { const size_t off = (size_t)rr * 1024 + 8 * F.lane + 512 * q; ra[u][q] = *(const v4u*)(YF + off); rb[u][q] = *(const v4u*)(YB + off); rz[u][q] = *(const v4u*)(PZ + off); } }
#pragma unroll
        for (int u = 0; u < NR; ++u) { const int row = row0 + u * NGW; if (row >= MALL) break;
            float v[16]; float ss = 0.f;
#pragma unroll
            for (int q = 0; q < 2; ++q) {
#pragma unroll
                for (int e = 0; e < 4; ++e) { const float y0 = bflo(ra[u][q][e]) + bflo(rb[u][q][e]), y1 = bfhi(ra[u][q][e]) + bfhi(rb[u][q][e]); const float z0 = bflo(rz[u][q][e]), z1 = bfhi(rz[u][q][e]);
                    const float r0 = y0 * siluf(z0), r1 = y1 * siluf(z1); v[8 * q + 2 * e] = r0; v[8 * q + 2 * e + 1] = r1; ss += r0 * r0 + r1 * r1; } }
            const float rstd = rsqrtf(wave_sum(ss) * (1.0f / 1024.0f) + NORM_EPS);
#pragma unroll
            for (int q = 0; q < 2; ++q) { const int c = 8 * F.lane + 512 * q; const f32x4 g0 = *(const f32x4*)(ng + c), g1 = *(const f32x4*)(ng + c + 4);
                v4u w; w.x = pk2(v[8 * q] * rstd * g0[0], v[8 * q + 1] * rstd * g0[1]); w.y = pk2(v[8 * q + 2] * rstd * g0[2], v[8 * q + 3] * rstd * g0[3]);
                w.z = pk2(v[8 * q + 4] * rstd * g1[0], v[8 * q + 5] * rstd * g1[1]); w.w = pk2(v[8 * q + 6] * rstd * g1[2], v[8 * q + 7] * rstd * g1[3]);
                *(v4u*)(CAT + (size_t)row * 2048 + c) = w; } }
    }
}
__device__ __forceinline__ void final_phase(Frame& F, const Args& A) {
    const int gw = F.bid * NWAVES + F.wave, NGW = F.G * NWAVES; const float* g = A.in[I_FINALG];
    for (int row = gw; row < MLAT; row += NGW) {
        float* xr = F.out + (size_t)row * DM; f32x4 v[4]; float ss = 0.f;
#pragma unroll
        for (int q = 0; q < 4; ++q) { v[q] = *(const f32x4*)(xr + 4 * F.lane + 256 * q); ss += (v[q][0] * v[q][0] + v[q][1] * v[q][1]) + (v[q][2] * v[q][2] + v[q][3] * v[q][3]); }
        const float rstd = rsqrtf(wave_sum(ss) * (1.0f / DM) + NORM_EPS);
#pragma unroll
        for (int q = 0; q < 4; ++q) { const int c = 4 * F.lane + 256 * q; const f32x4 gg = *(const f32x4*)(g + c); *(f32x4*)(xr + c) = v[q] * rstd * gg; }
    }
}

__device__ __forceinline__ void xbcconv_unit(Frame& F, const Args& A, int unit, int j) {
    const bool isctx = unit >= 192; const int u2 = isctx ? unit - 192 : unit; const int sq = u2 / 24, sl = u2 % 24;
    const int L = isctx ? CTXL : SEQ, R = L / 64; const int rowbase = isctx ? MLAT + sq * CTXL : sq * SEQ;
    const int pc = F.tid & 7, sg = F.tid >> 3; const int ch0 = 64 * sl + 8 * pc;
    bf16* base = (bf16*)(F.ws + WS_RA + RA_PXBC) + (size_t)rowbase * 1536 + ch0;
    const float* cwp = A.in[I_SCONVW] + (size_t)j * 3 * 1536 + ch0; const float* cbp = A.in[I_SCONVB] + (size_t)j * 1536 + ch0;
    float w0[8], w1[8], w2[8], bb[8];
#pragma unroll
    for (int e = 0; e < 8; ++e) { w0[e] = cwp[e]; w1[e] = cwp[1536 + e]; w2[e] = cwp[3072 + e]; bb[e] = cbp[e]; }
    const int r0 = sg * R; const v4u z4 = (v4u){0u, 0u, 0u, 0u};
    v4u prev = r0 > 0 ? *(const v4u*)(base + (size_t)(r0 - 1) * 1536) : z4;
    v4u nextb = r0 + R < L ? *(const v4u*)(base + (size_t)(r0 + R) * 1536) : z4;
    v4u cur = *(const v4u*)(base + (size_t)r0 * 1536);
    asm volatile("s_waitcnt vmcnt(0)" : "+v"(prev), "+v"(nextb), "+v"(cur) :: "memory");
    __syncthreads();
    for (int rb = 0; rb < R; rb += 4) {
        v4u nx[4];
#pragma unroll
        for (int k = 0; k < 4; ++k) { const int r = r0 + rb + k + 1; nx[k] = (rb + k + 1 < R) ? *(const v4u*)(base + (size_t)r * 1536) : nextb; }
#pragma unroll
        for (int k = 0; k < 4; ++k) {
            float o[8];
#pragma unroll
            for (int e = 0; e < 4; ++e) {
                const float v0 = w0[2 * e] * bflo(prev[e]) + w1[2 * e] * bflo(cur[e]) + w2[2 * e] * bflo(nx[k][e]) + bb[2 * e];
                const float v1 = w0[2 * e + 1] * bfhi(prev[e]) + w1[2 * e + 1] * bfhi(cur[e]) + w2[2 * e + 1] * bfhi(nx[k][e]) + bb[2 * e + 1];
                o[2 * e] = siluf(v0); o[2 * e + 1] = siluf(v1); }
            v4u pk; pk.x = pk2(o[0], o[1]); pk.y = pk2(o[2], o[3]); pk.z = pk2(o[4], o[5]); pk.w = pk2(o[6], o[7]);
            *(v4u*)(base + (size_t)(r0 + rb + k) * 1536) = pk;
            prev = cur; cur = nx[k];
        }
    }
    __syncthreads();
}

constexpr int SSD_Q = 128, SSD_LD = 136;
__device__ __forceinline__ void ssd_unit(Frame& F, const Args& A, int unit, int j) {
    const int b = unit >> 5, h = (unit >> 1) & 15, dir = unit & 1, g = h >> 3;
    const int tid = F.tid, lane = F.lane, w = F.wave, c = lane & 31, hh = lane >> 5;
    LAS bf16* xT = (LAS bf16*)F.lds;
    LAS bf16* Bm = xT + 64 * SSD_LD;
    LAS bf16* Cm = Bm + 128 * SSD_LD;
    LAS bf16* BwT = Cm + 128 * SSD_LD;
    LAS bf16* hL = BwT + 128 * SSD_LD;
    LAS float* dtL = (LAS float*)(hL + 64 * SSD_LD);
    LAS float* acL = dtL + 128;
    LAS float* wL = acL + 128;
    LAS float* gL = wL + 128;
    const bf16* PXBC = (const bf16*)(F.ws + WS_RA + RA_PXBC); const bf16* PDT = (const bf16*)(F.ws + WS_RA + RA_PDT);
    bf16* Y = (bf16*)(F.ws + WS_RA + (dir == 0 ? RA_PX1 : RA_PV));
    const float a_neg = -expf(A.in[I_SALOG][(j * 2 + dir) * 16 + h]); const float dtb = A.in[I_SDTB][(j * 2 + dir) * 16 + h]; const float Dh = dir == 0 ? A.in[I_SD][j * 16 + h] : 0.f;
    __syncthreads();
    for (int i = tid; i < 64 * SSD_LD / 2; i += NTHREADS) ((LAS unsigned*)hL)[i] = 0u;
    f32x16 hacc;
#pragma unroll
    for (int i = 0; i < 16; ++i) hacc[i] = 0.f;
    const int I = w & 3, pt = w >> 2;
    v4u pre[10]; unsigned short predt = 0;
#define SSD_PREFETCH(qq) do { const int sg_ = (qq) < 2 ? 0 : 1, ck_ = (qq) < 2 ? (qq) : (qq) - 2; const int L_ = sg_ == 0 ? CTXL : SEQ; const int rb_ = sg_ == 0 ? MLAT + b * CTXL : b * SEQ; \
        const int t0_ = dir == 0 ? ck_ * SSD_Q : L_ - (ck_ + 1) * SSD_Q; const int tb_ = dir == 0 ? rb_ + t0_ : rb_ + t0_ + SSD_Q - 1; const int ts_ = dir == 0 ? 1 : -1; \
        _Pragma("unroll") for (int k_ = 0; k_ < 2; ++k_) { const int it_ = tid + NTHREADS * k_; pre[k_] = *(const v4u*)(PXBC + (size_t)(tb_ + ts_ * (it_ & 127)) * 1536 + 64 * h + 8 * (it_ >> 7)); } \
        _Pragma("unroll") for (int k_ = 0; k_ < 4; ++k_) { const int it_ = tid + NTHREADS * k_; const bf16* p_ = PXBC + (size_t)(tb_ + ts_ * (it_ >> 4)) * 1536 + 1024 + 128 * g + 8 * (it_ & 15); \
            pre[2 + k_] = *(const v4u*)p_; pre[6 + k_] = *(const v4u*)(p_ + 256); } \
        if (tid < SSD_Q) predt = PDT[(size_t)(tb_ + ts_ * tid) * 32 + dir * 16 + h]; } while (0)
    SSD_PREFETCH(0);
    for (int qc = 0; qc < 18; ++qc) {
        const int seg = qc < 2 ? 0 : 1, ck = qc < 2 ? qc : qc - 2;
        const int L = seg == 0 ? CTXL : SEQ; const int rowbase = seg == 0 ? MLAT + b * CTXL : b * SEQ;
        {
            const int t0 = dir == 0 ? ck * SSD_Q : L - (ck + 1) * SSD_Q;
            __syncthreads();
#pragma unroll
            for (int k = 0; k < 2; ++k) { const int it = tid + NTHREADS * k; const int tau = it & 127, pc = it >> 7;
#pragma unroll
                for (int e = 0; e < 4; ++e) { xT[(8 * pc + 2 * e) * SSD_LD + tau] = (bf16)(pre[k][e] & 0xffffu); xT[(8 * pc + 2 * e + 1) * SSD_LD + tau] = (bf16)(pre[k][e] >> 16); } }
#pragma unroll
            for (int k = 0; k < 4; ++k) { const int it = tid + NTHREADS * k; const int tau = it >> 4, pc = it & 15;
                *(LAS v4u*)(Bm + tau * SSD_LD + 8 * pc) = pre[2 + k]; *(LAS v4u*)(Cm + tau * SSD_LD + 8 * pc) = pre[6 + k]; }
            if (tid < SSD_Q) { const float xx = bf2f(predt) + dtb; const float dt = xx > 20.f ? xx : log1pf(__expf(xx));
                float sc = dt * a_neg;
#pragma unroll
                for (int o = 1; o < 64; o <<= 1) { const float up = __shfl_up(sc, o); if (lane >= o) sc += up; }
                dtL[tid] = dt; acL[tid] = sc; }
            __syncthreads();
            const float ac63 = acL[63]; const float ac_last = acL[SSD_Q - 1] + ac63;
            if (tid < SSD_Q) { const int te = tid | 31; const float mine = acL[tid] + (tid >= 64 ? ac63 : 0.f), ace = acL[te] + (te >= 64 ? ac63 : 0.f); wL[tid] = mine; gL[tid] = __expf(ace - mine) * dtL[tid]; }
            for (int it = tid; it < SSD_Q * 16; it += NTHREADS) { const int tau = it & 127, pc = it >> 7;     const float wv = __expf(ac_last - (acL[tau] + (tau >= 64 ? ac63 : 0.f))) * dtL[tau];
                const v4u bv = *(const LAS v4u*)(Bm + tau * SSD_LD + 8 * pc);
#pragma unroll
                for (int e = 0; e < 4; ++e) { BwT[(8 * pc + 2 * e) * SSD_LD + tau] = (bf16)f2bf(bflo(bv[e]) * wv); BwT[(8 * pc + 2 * e + 1) * SSD_LD + tau] = (bf16)f2bf(bfhi(bv[e]) * wv); } }
            __syncthreads();
            if (qc + 1 < 18) SSD_PREFETCH(qc + 1);
            {
                bf16x8 Cf[8], Bf[8];
#pragma unroll
                for (int s = 0; s < 8; ++s) Cf[s] = *(const LAS bf16x8*)(Cm + (32 * I + c) * SSD_LD + 16 * s + 8 * hh);
#pragma unroll
                for (int s = 0; s < 8; ++s) Bf[s] = *(const LAS bf16x8*)(Bm + c * SSD_LD + 16 * s + 8 * hh);
                const float ac_i = wL[32 * I + c];
                f32x16 yd, yo;
#pragma unroll
                for (int i = 0; i < 16; ++i) { yd[i] = 0.f; yo[i] = 0.f; }
                for (int J = 0; J <= I; ++J) {
                    const float fi = J < I ? __expf(ac_i - wL[32 * J + 31]) : 1.0f;
                    v2u xa[2], xb[2];
#pragma unroll
                    for (int s2 = 0; s2 < 2; ++s2) { const LAS bf16* xp = xT + (32 * pt + c) * SSD_LD + 32 * J + 16 * s2 + 4 * hh; xa[s2] = *(const LAS v2u*)xp; xb[s2] = *(const LAS v2u*)(xp + 8); }
                    f32x16 T;
#pragma unroll
                    for (int i = 0; i < 16; ++i) T[i] = 0.f;
#pragma unroll
                    for (int s = 0; s < 8; ++s) T = __builtin_amdgcn_mfma_f32_32x32x16_bf16(Bf[s], Cf[s], T, 0, 0, 0);
                    if (J < I) {
#pragma unroll
                        for (int s = 0; s < 8; ++s) Bf[s] = *(const LAS bf16x8*)(Bm + (32 * (J + 1) + c) * SSD_LD + 16 * s + 8 * hh);
                    } else {
#pragma unroll
                        for (int s = 0; s < 8; ++s) Bf[s] = *(const LAS bf16x8*)(hL + (32 * pt + c) * SSD_LD + 16 * s + 8 * hh);
                    }
#pragma unroll
                    for (int r = 0; r < 16; ++r) { const int jj = 32 * J + (r & 3) + 8 * (r >> 2) + 4 * hh; const float ej = J < I ? gL[jj] * fi : ((jj <= 32 * I + c) ? __expf(ac_i - wL[jj]) * dtL[jj] : 0.f); T[r] = T[r] * ej; }
#pragma unroll
                    for (int s2 = 0; s2 < 2; ++s2) {
                        v4u mf; mf.x = pk2(T[8 * s2], T[8 * s2 + 1]); mf.y = pk2(T[8 * s2 + 2], T[8 * s2 + 3]); mf.z = pk2(T[8 * s2 + 4], T[8 * s2 + 5]); mf.w = pk2(T[8 * s2 + 6], T[8 * s2 + 7]);
                        v4u xf; xf.x = xa[s2].x; xf.y = xa[s2].y; xf.z = xb[s2].x; xf.w = xb[s2].y;
                        yd = __builtin_amdgcn_mfma_f32_32x32x16_bf16(__builtin_bit_cast(bf16x8, xf), __builtin_bit_cast(bf16x8, mf), yd, 0, 0, 0);
                    }
                }
#pragma unroll
                for (int s = 0; s < 8; ++s) yo = __builtin_amdgcn_mfma_f32_32x32x16_bf16(Bf[s], Cf[s], yo, 0, 0, 0);
                const float ei = __expf(ac_i);
                const int ti = dir == 0 ? t0 + 32 * I + c : t0 + SSD_Q - 1 - (32 * I + c);
                bf16* yrow = Y + (size_t)(rowbase + ti) * 1024 + 64 * h + 32 * pt + 4 * hh;
#pragma unroll
                for (int q = 0; q < 4; ++q) { float yv[4];
#pragma unroll
                    for (int e = 0; e < 4; ++e) { const int r = 4 * q + e; const int p = 32 * pt + e + 8 * q + 4 * hh; yv[e] = yd[r] + ei * yo[r] + Dh * bf2f(xT[p * SSD_LD + 32 * I + c]); }
                    v2u pk; pk.x = pk2(yv[0], yv[1]); pk.y = pk2(yv[2], yv[3]); *(v2u*)(yrow + 8 * q) = pk; }
            }
            __syncthreads();
            {
                const float dec = __expf(ac_last);
#pragma unroll
                for (int i = 0; i < 16; ++i) hacc[i] *= dec;
                bf16x8 Xf[8], Wf[8];
#pragma unroll
                for (int s = 0; s < 8; ++s) { Xf[s] = *(const LAS bf16x8*)(xT + (32 * pt + c) * SSD_LD + 16 * s + 8 * hh); Wf[s] = *(const LAS bf16x8*)(BwT + (32 * I + c) * SSD_LD + 16 * s + 8 * hh); }
#pragma unroll
                for (int s = 0; s < 8; ++s) hacc = __builtin_amdgcn_mfma_f32_32x32x16_bf16(Xf[s], Wf[s], hacc, 0, 0, 0);
#pragma unroll
                for (int r = 0; r < 16; ++r) { const int p = 32 * pt + (r & 3) + 8 * (r >> 2) + 4 * hh; hL[p * SSD_LD + 32 * I + c] = (bf16)f2bf(hacc[r]); }
            }
        }
    }
#undef SSD_PREFETCH
    __syncthreads();
}

constexpr int HY_UB = 40, HY_CH = 128 * HY_UB;
__device__ __forceinline__ void hyena_unit(Frame& F, const Args& A, int unit, int j) {
    const bool isctx = unit >= 1024; const int cg8 = isctx ? unit - 1024 : (unit & 127); const int c0 = 8 * cg8;
    const int L = isctx ? CTXL : SEQ, nblk = isctx ? 8 : 64; const int rowbase = isctx ? MLAT : (unit >> 7) * SEQ;
    const int tid = F.tid, lane = F.lane, w = F.wave;
    LAS bf16* Ul = (LAS bf16*)F.lds + 32 * HY_UB;
    LAS bf16* Fl = (LAS bf16*)(F.lds + 81920);
    LAS float* Ys = (LAS float*)(F.lds + 81920);
    const bf16* PX0 = (const bf16*)(F.ws + WS_RA + RA_PX0) + ((size_t)cg8 * MALL + rowbase) * 8;
    const bf16* PX1 = (const bf16*)(F.ws + WS_RA + RA_PX1) + ((size_t)cg8 * MALL + rowbase) * 8;
    const bf16* PV = (const bf16*)(F.ws + WS_RA + RA_PV) + ((size_t)cg8 * MALL + rowbase) * 8;
    const bf16* Fg = (const bf16*)(F.ws + WS_F + (size_t)j * F_LAYER + (isctx ? 8 * MiB : 0)) + (size_t)c0 * 2 * L;
    const float* SS = (const float*)(F.ws + WS_CTL) + (j * 2 + (isctx ? 1 : 0)) * 1024;
    const float* hcw = A.in[I_HCONVW] + (size_t)j * 3 * 3072; const float* hcb = A.in[I_HCONVB] + (size_t)j * 3072;
    bf16* CAT = (bf16*)(F.ws + WS_RB);
    __syncthreads();
    for (int i = tid; i < 8 * 2 * 160; i += NTHREADS) { const int ch = i / 320, r = i % 320; const int side = r / 160, pz = r % 160;
        *(LAS v4u*)(Ul + ch * HY_CH + (side ? 64 : -32) * HY_UB + 8 * pz) = (v4u){0u, 0u, 0u, 0u}; }
    if (!isctx) { v4u fv[8];
#pragma unroll
        for (int k = 0; k < 8; ++k) fv[k] = *(const v4u*)(Fg + (size_t)k * 2 * SEQ + 8 * tid);
#pragma unroll
        for (int k = 0; k < 8; ++k) *(LAS v4u*)(Fl + k * 4096 + 8 * tid) = fv[k];
    } else { const int ch = tid >> 6, pz = tid & 63; *(LAS v4u*)(Fl + ch * 4096 + 8 * pz) = *(const v4u*)(Fg + (size_t)ch * 2 * CTXL + 8 * pz); }
    {
        v4u ra[4][3], rv[4][3];
#pragma unroll
        for (int q = 0; q < 4; ++q) { const int ru = tid + NTHREADS * q; const int t = ru & (L - 1); const v4u z4 = (v4u){0u, 0u, 0u, 0u};
            ra[q][0] = t > 0 ? *(const v4u*)(PX1 + (size_t)(ru - 1) * 8) : z4; ra[q][1] = *(const v4u*)(PX1 + (size_t)ru * 8); ra[q][2] = t < L - 1 ? *(const v4u*)(PX1 + (size_t)(ru + 1) * 8) : z4;
            rv[q][0] = t > 0 ? *(const v4u*)(PV + (size_t)(ru - 1) * 8) : z4; rv[q][1] = *(const v4u*)(PV + (size_t)ru * 8); rv[q][2] = t < L - 1 ? *(const v4u*)(PV + (size_t)(ru + 1) * 8) : z4; }
#pragma unroll
        for (int q = 0; q < 4; ++q) { const int ru = tid + NTHREADS * q; LAS bf16* up = Ul + (ru >> 5) * HY_UB + ((ru & 31) ^ 7);
#pragma unroll
            for (int e = 0; e < 4; ++e) {
#pragma unroll
                for (int hl = 0; hl < 2; ++hl) { const int ch = 2 * e + hl; const int c1 = 1024 + c0 + ch, c2 = 2048 + c0 + ch;
                    const float x0_ = hl ? bfhi(ra[q][0][e]) : bflo(ra[q][0][e]), x1_ = hl ? bfhi(ra[q][1][e]) : bflo(ra[q][1][e]), x2_ = hl ? bfhi(ra[q][2][e]) : bflo(ra[q][2][e]);
                    const float v0_ = hl ? bfhi(rv[q][0][e]) : bflo(rv[q][0][e]), v1_ = hl ? bfhi(rv[q][1][e]) : bflo(rv[q][1][e]), v2_ = hl ? bfhi(rv[q][2][e]) : bflo(rv[q][2][e]);
                    const float xc = hcw[c1] * x0_ + hcw[3072 + c1] * x1_ + hcw[6144 + c1] * x2_ + hcb[c1];
                    const float vc = hcw[c2] * v0_ + hcw[3072 + c2] * v1_ + hcw[6144 + c2] * v2_ + hcb[c2];
                    up[ch * (HY_CH)] = (bf16)f2bf(xc * vc); } } }
    }
    __syncthreads();
    f32x16 acc0, acc1;
#pragma unroll
    for (int i = 0; i < 16; ++i) { acc0[i] = 0.f; acc1[i] = 0.f; }
    {
        const int il = lane & 31, hh = lane >> 5;
        const LAS bf16* fw = Fl + w * 4096; const LAS bf16* uw = Ul + w * (HY_CH);
        const int I0 = il & (nblk - 1), I1 = (32 + il) & (nblk - 1);
        const bf16x8 zf = (bf16x8){0, 0, 0, 0, 0, 0, 0, 0};
        const int sh = (il + 1) & 3; const bool odw = (sh >> 1) != 0; const unsigned obit = (unsigned)(sh & 1) * 16u;
#define HY_LOAD(R0, R1, R2, B0, B1, D_, s_) do { const int al_ = L + 32 * (D_) - 16 * (s_) - 8 * hh + il - 7 - sh; \
            const LAS v2u* fp_ = (const LAS v2u*)(fw + al_); R0 = fp_[0]; R1 = fp_[1]; R2 = fp_[2]; \
            if (isctx) { const int J0_ = I0 - (D_), J1_ = I1 - (D_); B0 = zf; B1 = zf; \
                if (J0_ >= 0 && J0_ < nblk) B0 = *(const LAS bf16x8*)(uw + (il - (D_)) * HY_UB + 16 * (s_) + 8 * hh); \
                if (J1_ >= 0 && J1_ < nblk) B1 = *(const LAS bf16x8*)(uw + (32 + il - (D_)) * HY_UB + 16 * (s_) + 8 * hh); } \
            else { B0 = *(const LAS bf16x8*)(uw + (il - (D_)) * HY_UB + 16 * (s_) + 8 * hh); B1 = *(const LAS bf16x8*)(uw + (32 + il - (D_)) * HY_UB + 16 * (s_) + 8 * hh); } } while (0)
#define HY_FIX(AF, R0, R1, R2) do { \
            const unsigned s0_ = odw ? R0.y : R0.x, s1_ = odw ? R1.x : R0.y, s2_ = odw ? R1.y : R1.x, s3_ = odw ? R2.x : R1.y, s4_ = odw ? R2.y : R2.x; \
            v4u af_; af_.x = __builtin_amdgcn_alignbit(s1_, s0_, obit); af_.y = __builtin_amdgcn_alignbit(s2_, s1_, obit); af_.z = __builtin_amdgcn_alignbit(s3_, s2_, obit); af_.w = __builtin_amdgcn_alignbit(s4_, s3_, obit); \
            AF = __builtin_bit_cast(bf16x8, af_); } while (0)
        bf16x8 a0, b00, b01, a1, b10, b11; v2u p0, p1, p2, q0, q1, q2;
        const int Dlo = -(nblk - 1), Dhi = nblk - 1;
        HY_LOAD(p0, p1, p2, b00, b01, Dlo, 0);
#define HY_BODY(T0, T1) { \
            HY_LOAD(q0, q1, q2, b10, b11, D, 1);                                     \
            HY_FIX(a0, p0, p1, p2); \
            __builtin_amdgcn_s_setprio(1); \
            if (T0) acc0 = __builtin_amdgcn_mfma_f32_32x32x16_bf16(a0, b00, acc0, 0, 0, 0); \
            if (T1) acc1 = __builtin_amdgcn_mfma_f32_32x32x16_bf16(a0, b01, acc1, 0, 0, 0); \
            __builtin_amdgcn_s_setprio(0); \
            bf16x8 n00, n01; const int Dn = D < Dhi ? D + 1 : Dhi;                    \
            HY_LOAD(p0, p1, p2, n00, n01, Dn, 0);                                    \
            HY_FIX(a1, q0, q1, q2); \
            __builtin_amdgcn_s_setprio(1); \
            if (T0) acc0 = __builtin_amdgcn_mfma_f32_32x32x16_bf16(a1, b10, acc0, 0, 0, 0); \
            if (T1) acc1 = __builtin_amdgcn_mfma_f32_32x32x16_bf16(a1, b11, acc1, 0, 0, 0); \
            __builtin_amdgcn_s_setprio(0); \
            b00 = n00; b01 = n01; }
        {
            if (isctx) { for (int D = Dlo; D <= Dhi; ++D) HY_BODY(1, 1) }
            else { for (int D = Dlo; D <= -32; ++D) HY_BODY(1, 0)
                   for (int D = -31; D <= 31; ++D) HY_BODY(1, 1)
                   for (int D = 32; D <= Dhi; ++D) HY_BODY(0, 1) }
        }
#undef HY_BODY
#undef HY_FIX
#undef HY_LOAD
    }
    __syncthreads();
    {
        const int il = lane & 31, hh = lane >> 5; LAS float* yw = Ys + w * (64 * 33);
#pragma unroll
        for (int r = 0; r < 16; ++r) { const int irow = (r & 3) + 8 * (r >> 2) + 4 * hh; yw[33 * il + irow] = acc0[r]; yw[33 * (32 + il) + irow] = acc1[r]; }
    }
    __syncthreads();
    {
        v4u rx[4][3];
#pragma unroll
        for (int q = 0; q < 4; ++q) { const int ru = tid + NTHREADS * q; const int t = ru & (L - 1); const v4u z4 = (v4u){0u, 0u, 0u, 0u};
            rx[q][0] = t > 0 ? *(const v4u*)(PX0 + (size_t)(ru - 1) * 8) : z4; rx[q][1] = *(const v4u*)(PX0 + (size_t)ru * 8); rx[q][2] = t < L - 1 ? *(const v4u*)(PX0 + (size_t)(ru + 1) * 8) : z4; }
#pragma unroll
        for (int q = 0; q < 4; ++q) { const int ru = tid + NTHREADS * q; const size_t m = (size_t)(rowbase + ru);
            const LAS bf16* up = Ul + (ru >> 5) * HY_UB + ((ru & 31) ^ 7);     const LAS float* yp = Ys + 33 * (ru >> 5) + (ru & 31);
            float o[8];
#pragma unroll
            for (int e = 0; e < 4; ++e) {
#pragma unroll
                for (int hl = 0; hl < 2; ++hl) { const int ch = 2 * e + hl; const int cc = c0 + ch;
                    const float x0_ = hl ? bfhi(rx[q][0][e]) : bflo(rx[q][0][e]), x1_ = hl ? bfhi(rx[q][1][e]) : bflo(rx[q][1][e]), x2_ = hl ? bfhi(rx[q][2][e]) : bflo(rx[q][2][e]);
                    const float xc = hcw[cc] * x0_ + hcw[3072 + cc] * x1_ + hcw[6144 + cc] * x2_ + hcb[cc];
                    const float uu = bf2f(up[ch * (HY_CH)]); const float yv = yp[ch * (64 * 33)];
                    const float sc = rsqrtf(SS[cc] + 1e-6f);
                    o[ch] = xc * (sc * yv + A.in[I_HBIAS][j * 1024 + cc] * uu); } }
            v4u wv; wv.x = pk2(o[0], o[1]); wv.y = pk2(o[2], o[3]); wv.z = pk2(o[4], o[5]); wv.w = pk2(o[6], o[7]);
            *(v4u*)(CAT + m * 2048 + 1024 + c0) = wv; }
    }
    __syncthreads();
}

constexpr int AT_LD = 72;
__device__ __forceinline__ void attn_unit(Frame& F, const Args& A, int unit, int jl) {
    const bool isctx = unit >= 1024; int b, g, qb;
    if (!isctx) { b = unit >> 7; g = (unit >> 5) & 3; qb = unit & 31; } else { const int u2 = unit - 1024; b = u2 >> 4; g = (u2 >> 2) & 3; qb = u2 & 3; }
    const int tid = F.tid, lane = F.lane, w = F.wave, l15 = lane & 15, l4 = lane >> 4;
    const int hq = 4 * g + (w >> 1); const int qoff = qb * 64 + (w & 1) * 32;
    const int qrow0 = (isctx ? MLAT + b * CTXL : b * SEQ) + qoff;
    const bf16* Q = (const bf16*)(F.ws + WS_RA + RA_Q); const bf16* K = (const bf16*)(F.ws + WS_RA + RA_K); const bf16* V = (const bf16*)(F.ws + WS_RA + RA_V);
    bf16* O = (bf16*)(F.ws + WS_RB + SZ_M1024);
    LAS bf16* Kl = (LAS bf16*)F.lds;
    LAS bf16* Vl = Kl + 4 * 64 * AT_LD;
    const int l31 = lane & 31, hh = lane >> 5;
    bf16x8 Qf[4];
#pragma unroll
    for (int ks = 0; ks < 4; ++ks) Qf[ks] = *(const bf16x8*)(Q + (size_t)(qrow0 + l31) * 1024 + hq * 64 + 16 * ks + 8 * hh);
    float mrow = -1e30f, lrow = 0.f; f32x16 Oa[2];
#pragma unroll
    for (int i = 0; i < 16; ++i) { Oa[0][i] = 0.f; Oa[1][i] = 0.f; }
    const int c_lo = isctx ? 0 : ((qb * 64 - 128) < 0 ? (128 - qb * 64) / 64 : 0);
    const int c_hi = isctx ? -1 : ((qb * 64 + 128 + 64) > SEQ ? 4 - (qb * 64 + 192 - SEQ) / 64 : 4);
    const int nck = 4 + (isctx ? 0 : (c_hi - c_lo + 1));
    const int kr = tid & 63, kp = tid >> 6;
#define AT_ROW0(ck_) ((ck_) < 4 ? MLAT + b * CTXL + 64 * (ck_) : b * SEQ + qb * 64 - 128 + 64 * ((ck_) - 4 + c_lo))
    v4u pkA, pvA, pkB, pvB;
    { const size_t r = (size_t)(AT_ROW0(0) + kr) * 256 + g * 64 + 8 * kp; pkA = *(const v4u*)(K + r); pvA = *(const v4u*)(V + r); }
    { const size_t r = (size_t)(AT_ROW0(1) + kr) * 256 + g * 64 + 8 * kp; pkB = *(const v4u*)(K + r); pvB = *(const v4u*)(V + r); }
    __syncthreads();
#define AT_COMPUTE(BUFO) { const int bufo = (BUFO); \
        const int cw_ = ck - 4 + c_lo; const bool masked = ck >= 4 && (cw_ == 0 || cw_ == 4); const int kc0 = qb * 64 - 128 + 64 * cw_;    \
        f32x16 St[2]; \
        _Pragma("unroll") \
        for (int kt = 0; kt < 2; ++kt) { \
        _Pragma("unroll") \
            for (int i = 0; i < 16; ++i) St[kt][i] = 0.f; \
        _Pragma("unroll") \
            for (int ks = 0; ks < 4; ++ks) { const bf16x8 kf = *(const LAS bf16x8*)(Kl + bufo + (32 * kt + l31) * AT_LD + 16 * ks + 8 * hh); \
                St[kt] = __builtin_amdgcn_mfma_f32_32x32x16_bf16(kf, Qf[ks], St[kt], 0, 0, 0); } } \
        if (masked) { const int qi = qoff + l31; \
        _Pragma("unroll") \
            for (int kt = 0; kt < 2; ++kt) \
        _Pragma("unroll") \
                for (int r = 0; r < 16; ++r) { const int kj = kc0 + 32 * kt + (r & 3) + 8 * (r >> 2) + 4 * hh; const int d = qi - kj; if (d > 128 || d < -128) St[kt][r] = -1e30f; } } \
        float mx = St[0][0]; \
        _Pragma("unroll") \
        for (int r = 1; r < 16; ++r) mx = fmaxf(mx, St[0][r]); \
        _Pragma("unroll") \
        for (int r = 0; r < 16; ++r) mx = fmaxf(mx, St[1][r]); \
        mx = fmaxf(mx, __shfl_xor(mx, 32)); \
        const float mn = fmaxf(mrow, mx); const float alpha = __builtin_amdgcn_exp2f(mrow - mn); mrow = mn; \
        float ps = 0.f; \
        _Pragma("unroll") \
        for (int kt = 0; kt < 2; ++kt) \
        _Pragma("unroll") \
            for (int r = 0; r < 16; ++r) { const float pv = __builtin_amdgcn_exp2f(St[kt][r] - mn); St[kt][r] = pv; ps += pv; } \
        lrow = lrow * alpha + ps; \
        _Pragma("unroll") \
        for (int i = 0; i < 16; ++i) { Oa[0][i] *= alpha; Oa[1][i] *= alpha; } \
        _Pragma("unroll") \
        for (int kt = 0; kt < 2; ++kt) \
        _Pragma("unroll") \
            for (int s2 = 0; s2 < 2; ++s2) { \
                v4u pf; pf.x = pk2(St[kt][8 * s2], St[kt][8 * s2 + 1]); pf.y = pk2(St[kt][8 * s2 + 2], St[kt][8 * s2 + 3]); pf.z = pk2(St[kt][8 * s2 + 4], St[kt][8 * s2 + 5]); pf.w = pk2(St[kt][8 * s2 + 6], St[kt][8 * s2 + 7]); \
        _Pragma("unroll") \
                for (int dt = 0; dt < 2; ++dt) { const LAS bf16* vp = Vl + bufo + (32 * dt + l31) * AT_LD + 32 * kt + 16 * s2 + 4 * hh; \
                    const v2u va = *(const LAS v2u*)vp, vb = *(const LAS v2u*)(vp + 8); \
                    v4u vf; vf.x = va.x; vf.y = va.y; vf.z = vb.x; vf.w = vb.y; \
                    Oa[dt] = __builtin_amdgcn_mfma_f32_32x32x16_bf16(__builtin_bit_cast(bf16x8, vf), __builtin_bit_cast(bf16x8, pf), Oa[dt], 0, 0, 0); } \
            } \
     \
    }
#define AT_STAGE(PK, PV, BUFO) { const int bo_ = (BUFO); *(LAS v4u*)(Kl + bo_ + kr * AT_LD + 8 * kp) = PK; \
        _Pragma("unroll") for (int e = 0; e < 4; ++e) { Vl[bo_ + (8 * kp + 2 * e) * AT_LD + kr] = (bf16)(PV[e] & 0xffffu); Vl[bo_ + (8 * kp + 2 * e + 1) * AT_LD + kr] = (bf16)(PV[e] >> 16); } \
        __syncthreads(); \
        if (ck + 2 < nck) { const size_t r = (size_t)(AT_ROW0(ck + 2) + kr) * 256 + g * 64 + 8 * kp; PK = *(const v4u*)(K + r); PV = *(const v4u*)(V + r); } }
    for (int ck = 0; ck < nck; ck += 2) {
        AT_STAGE(pkA, pvA, 0) AT_COMPUTE(0)
        if (ck + 1 < nck) { ++ck; AT_STAGE(pkB, pvB, 64 * AT_LD) AT_COMPUTE(64 * AT_LD) --ck; }
    }
#undef AT_STAGE
#undef AT_COMPUTE
#undef AT_ROW0
    const float sink2 = A.in[I_SINKS][jl * 16 + hq] * 1.4426950408889634f;
    const float ltot = lrow + __shfl_xor(lrow, 32);
    const float inv = 1.0f / (ltot + exp2f(sink2 - mrow));
    bf16* orow = O + (size_t)(qrow0 + l31) * 1024 + hq * 64 + 4 * hh;
#pragma unroll
    for (int dt = 0; dt < 2; ++dt)
#pragma unroll
        for (int q4 = 0; q4 < 4; ++q4) { v2u pk; pk.x = pk2(Oa[dt][4 * q4] * inv, Oa[dt][4 * q4 + 1] * inv); pk.y = pk2(Oa[dt][4 * q4 + 2] * inv, Oa[dt][4 * q4 + 3] * inv);
            *(v2u*)(orow + 32 * dt + 8 * q4) = pk; }
}

constexpr int LDS_BYTES = 155648;
constexpr int NPHASE = 2 + 2 * 9 + 2 * 7;

#ifndef REP_GEMM
#define REP_GEMM 1
#endif
#ifndef REP_E3
#define REP_E3 1
#endif
#ifndef REP_ATT
#define REP_ATT 1
#endif
#ifndef REP_NM
#define REP_NM 1
#endif
#ifndef REP_P0
#define REP_P0 1
#endif
#ifndef REP_SYNC
#define REP_SYNC 1
#endif
#define PHASE_BEGIN if (ph >= lo && ph < hi) {
#define PHASE_END   if (ph + 1 < hi) { if (ph == lo) cg::this_grid().sync(); else xcd_barrier(bar); } } ++ph;
template <int layer> __device__ __forceinline__ void layer_body(Frame& F, const Args& A, const XcdBarrier& bar, int& ph, const int lo, const int hi) {
    constexpr int j = layer >> 1; constexpr bool need_ctx = layer < DEPTH - 1; constexpr int Mrows = need_ctx ? MALL : MLAT;

        const float* modl = (const float*)(F.ws + WS_MOD) + (size_t)layer * 9 * MODW;
        if constexpr ((layer & 1) == 0) {
            PHASE_BEGIN
                pg8::Gemm g{(const pg8::bf16_t*)(F.ws + WS_RB), (const pg8::bf16_t*)(F.ws + WS_WA), MALL, INP, DM}; pg8::StaticOrder S; S.init(MALL, INP, F.G, F.bid);
                pg8::EpiInProj E{F.ws + WS_RA};
                for (int rep_ = 0; rep_ < REP_GEMM; ++rep_) { pg8::gemm_phase<pg8::EpiInProj, pg8::StaticOrder, true, true>(F.lds, g, S, E); }
            PHASE_END
            PHASE_BEGIN
                for (int u = F.bid; u < 1152; u += F.G) hyena_unit(F, A, u, j);
                for (int u = F.G - 1 - F.bid; u < 384; u += F.G) xbcconv_unit(F, A, u, j);
            PHASE_END
            PHASE_BEGIN
                for (int u = F.bid; u < 256; u += F.G) ssd_unit(F, A, u, j);
            PHASE_END
            PHASE_BEGIN
                for (int rep_ = 0; rep_ < REP_NM; ++rep_) gate_phase(F, A, j);
            PHASE_END
            PHASE_BEGIN
                pg8::Gemm g{(const pg8::bf16_t*)(F.ws + WS_RB), (const pg8::bf16_t*)(F.ws + WS_WB), MALL, DM, 2048}; pg8::SplitOrder S; S.init(MALL, DM, 2048, F.G, F.bid, F.G == 256 ? 8 : 1);
                pg8::EpiResidT<layer == 0> E{F.out, (float*)(F.ws + WS_XC), modl + 2 * DM, (float*)(F.ws + WS_RA), A.in[I_X], A.in[I_CTX]};
                pg8::gemm_phase<pg8::EpiResidT<layer == 0>, pg8::SplitOrder, true, true>(F.lds, g, S, E);
            PHASE_END
        } else {
            PHASE_BEGIN
                pg8::Gemm g{(const pg8::bf16_t*)(F.ws + WS_RB), (const pg8::bf16_t*)(F.ws + WS_WA), MALL, QKV_COLS, DM}; pg8::StaticOrder S; S.init(MALL, QKV_COLS, F.G, F.bid);
                pg8::EpiQKV E{F.ws + WS_RA, (const float*)(F.ws + WS_ROPE), 0.125f * 1.4426950408889634f};
                for (int rep_ = 0; rep_ < REP_GEMM; ++rep_) { pg8::gemm_phase<pg8::EpiQKV, pg8::StaticOrder, true, true>(F.lds, g, S, E); }
            PHASE_END
            PHASE_BEGIN
                const int nu = need_ctx ? 1152 : 1024;
#ifndef NO_ATTN
                for (int u = F.bid; u < nu; u += F.G) attn_unit(F, A, u, j);
#endif
            PHASE_END
            PHASE_BEGIN
                pg8::Gemm g{(const pg8::bf16_t*)(F.ws + WS_RB + SZ_M1024), (const pg8::bf16_t*)(F.ws + WS_WB), Mrows, DM, DM}; pg8::SplitOrder S; S.init(Mrows, DM, DM, F.G, F.bid, F.G == 256 ? 8 : 1);
                pg8::EpiResidT<false> E{F.out, (float*)(F.ws + WS_XC), modl + 2 * DM, (float*)(F.ws + WS_RA), nullptr, nullptr};
                pg8::gemm_phase<pg8::EpiResidT<false>, pg8::SplitOrder, true, true>(F.lds, g, S, E);
            PHASE_END
        }
        PHASE_BEGIN
            for (int rep_ = 0; rep_ < REP_NM; ++rep_) nm_phase(F, A, layer, 3, A.in[I_N2G] + layer * DM, Mrows, (need_ctx && F.G == 256) ? (const float*)(F.ws + WS_RA) : nullptr, 8, (const float*)F.out, (layer == 0 && F.G == 256) ? A.in[I_CTX] : (const float*)(F.ws + WS_XC));
        PHASE_END
        PHASE_BEGIN
            pg8::Gemm g{(const pg8::bf16_t*)(F.ws + WS_RB), (const pg8::bf16_t*)(F.ws + WS_WC), Mrows, 2 * FFH, DM}; pg8::StaticOrder S; S.init(Mrows, 2 * FFH, F.G, F.bid);
            pg8::EpiSwiGLU E{(pg8::bf16_t*)(F.ws + WS_RA)};
            for (int rep_ = 0; rep_ < REP_GEMM; ++rep_) { pg8::gemm_phase<pg8::EpiSwiGLU, pg8::StaticOrder, true, true>(F.lds, g, S, E); }
            if (layer + 1 < DEPTH) { const int tail = S.nwg % F.G; __syncthreads(); convert_weights(F, A, layer + 1, 1, tail < F.G / 2 ? tail : 0); }
        PHASE_END
        PHASE_BEGIN
            pg8::Gemm g{(const pg8::bf16_t*)(F.ws + WS_RA), (const pg8::bf16_t*)(F.ws + WS_WD), Mrows, DM, FFH}; pg8::SplitOrder S; S.init(Mrows, DM, FFH, F.G, F.bid, F.G == 256 ? 2 : 1);
            pg8::EpiResidT<false> E{F.out, (float*)(F.ws + WS_XC), modl + 5 * DM, (float*)(F.ws + WS_RB + 40 * MiB), nullptr, nullptr};
            pg8::gemm_phase<pg8::EpiResidT<false>, pg8::SplitOrder, true, true>(F.lds, g, S, E);
        PHASE_END
        PHASE_BEGIN
            if (layer + 1 < DEPTH) { convert_weights(F, A, layer + 1, 2, 0); nm_phase(F, A, layer + 1, 0, A.in[I_N1G] + (layer + 1) * DM, MALL, (need_ctx && F.G == 256) ? (const float*)(F.ws + WS_RB + 40 * MiB) : nullptr, 2, (const float*)F.out, (const float*)(F.ws + WS_XC)); }
            else final_phase(F, A);
        PHASE_END
    }
#undef PHASE_BEGIN
#undef PHASE_END

__global__ void __launch_bounds__(NTHREADS, 2) fwd_kernel(Args A) {
    extern __shared__ __attribute__((aligned(16))) unsigned char lds_raw[];
    Frame F;
    F.lds = (LAS unsigned char*)lds_raw;
    F.tid = threadIdx.x; F.lane = F.tid & 63; F.wave = __builtin_amdgcn_readfirstlane(F.tid >> 6); F.G = gridDim.x; F.bid = blockIdx.x;
    F.out = A.out; F.ws = A.ws;
    const int lo = A.ph_lo, hi = A.ph_hi;
    int ph = 0;
    volatile LAS unsigned* bst = (volatile LAS unsigned*)(F.lds + LDS_BYTES - 64);
    if (F.tid < 2) bst[F.tid] = 0u;
    __syncthreads();
    XcdBarrier bar; bar.bar = (unsigned*)(F.ws + WS_CTL + 32768); bar.x = 0; bar.st = bst;
    if (hi - lo > 1) bar = xcd_barrier_post((unsigned*)(F.ws + WS_CTL + 32768), bst);
#define PHASE_BEGIN if (ph >= lo && ph < hi) {
#define PHASE_END   if (ph + 1 < hi) { if (ph == lo) cg::this_grid().sync(); else xcd_barrier(bar); } } ++ph;

    PHASE_BEGIN
#ifndef NO_P0
        for (int rep_ = 0; rep_ < REP_P0; ++rep_) {
        for (int u = F.bid; u < 576; u += F.G) filter_unit(F, A, u);
        for (int u = F.bid; u < 384; u += F.G) mod_unit(F, A, u);
        copy_inputs(F, A);
        convert_weights(F, A, 0, 3, 0);
        }
#endif
    PHASE_END
    PHASE_BEGIN
        nm_phase(F, A, 0, 0, A.in[I_N1G], MALL, nullptr, 1, A.in[I_X], A.in[I_CTX]);
    PHASE_END

    layer_body<0>(F, A, bar, ph, lo, hi);
    layer_body<1>(F, A, bar, ph, lo, hi);
    layer_body<2>(F, A, bar, ph, lo, hi);
    layer_body<3>(F, A, bar, ph, lo, hi);
#undef PHASE_BEGIN
#undef PHASE_END
}

extern "C" void kernel_launch(void* const* d_in, const int* in_sizes, int n_in, void* d_out, int out_size, void* d_ws, size_t ws_size, hipStream_t stream) {
    static int grid = 0;
    if (grid == 0) {
        if (n_in != 33 || out_size != MLAT * DM || ws_size < WS_END) { fprintf(stderr, "kernel_launch: unexpected shapes (n_in %d out %d ws %zu)\n", n_in, out_size, ws_size); grid = -1; return; }
        int dev = 0, cus = 0, per_cu = 0;
        if (hipGetDevice(&dev) != hipSuccess || hipDeviceGetAttribute(&cus, hipDeviceAttributeMultiprocessorCount, dev) != hipSuccess) { grid = -1; return; }
        if (hipFuncSetAttribute((const void*)fwd_kernel, hipFuncAttributeMaxDynamicSharedMemorySize, LDS_BYTES) != hipSuccess) { fprintf(stderr, "kernel_launch: hipFuncSetAttribute failed\n"); grid = -1; return; }
        if (hipOccupancyMaxActiveBlocksPerMultiprocessor(&per_cu, (const void*)fwd_kernel, NTHREADS, LDS_BYTES) != hipSuccess || per_cu < 1) { fprintf(stderr, "kernel_launch: occupancy query failed (%d)\n", per_cu); (void)hipGetLastError(); per_cu = 1; }
        grid = cus;
        if (grid > 256) grid = 256;
    }
    if (grid < 0) return;
    (void)hipMemsetAsync((char*)d_ws + WS_CTL, 0, CTL_BYTES, stream);
    Args a{};
    for (int i = 0; i < 33; ++i) a.in[i] = (const float*)d_in[i];
    a.out = (float*)d_out; a.ws = (unsigned char*)d_ws;
#ifndef N_LAUNCH_PER_PHASE
#define N_LAUNCH_PER_PHASE 0
#endif
#if N_LAUNCH_PER_PHASE
#ifndef PROBE_MASK
#define PROBE_MASK 0u
#endif
#ifndef PROBE_DRY
#define PROBE_DRY 1
#endif
#ifndef PROBE_REPS
#define PROBE_REPS 2
#endif
    for (int p = 0; p < NPHASE; ++p) {
        const int reps = ((PROBE_MASK >> p) & 1u) ? PROBE_REPS : 1;
        for (int r = 0; r < reps; ++r) {
            a.ph_lo = p; a.ph_hi = p + 1; a.dry = (r + 1 < reps) ? PROBE_DRY : 0;
            void* kargs[] = {&a};
            hipError_t e = hipLaunchCooperativeKernel((const void*)fwd_kernel, dim3(grid), dim3(NTHREADS), kargs, LDS_BYTES, stream);
            if (e != hipSuccess) { fprintf(stderr, "kernel_launch: launch %d failed: %s\n", p, hipGetErrorString(e)); break; }
        }
    }
#else
    a.ph_lo = 0; a.ph_hi = NPHASE;
    void* kargs[] = {&a};
    hipError_t e = hipLaunchCooperativeKernel((const void*)fwd_kernel, dim3(grid), dim3(NTHREADS), kargs, LDS_BYTES, stream);
    if (e != hipSuccess) fprintf(stderr, "kernel_launch: cooperative launch failed: %s (grid %d)\n", hipGetErrorString(e), grid);
#endif
}
```
